# Optimizing an MI355X kernel written in HIP

```python
import jax, jax.numpy as jnp
from jax import lax
import numpy as np

D_MODEL = 1024
BATCH = 8
SEQ = 2048
DEPTH = 4
DEC_BATCH = 32
DEC_SEQ = 8
PAST_LEN = 8192
PAGE_SIZE = 128

N_EVEN = (DEPTH + 1) // 2
N_ODD = DEPTH // 2
A_WIDTH = D_MODEL // 2
A_HEAD_DIM = 64
A_HEADS = A_WIDTH // A_HEAD_DIM
A_DECAY_RANK = 64
A_ICLR_RANK = 64
A_SHIFT_W = 3 * A_WIDTH + A_DECAY_RANK + A_ICLR_RANK
GN_EPS = 64e-5
B_WIDTH = D_MODEL // 2
CONV_W = 3
EVEN_IN_W = A_SHIFT_W + A_WIDTH + 4 * B_WIDTH
EVEN_MIX_W = A_WIDTH + B_WIDTH
C_GROUPS = ((128, 1), (512, 4), (2048, 16))
N_C_GROUPS = len(C_GROUPS)
C_HEADS = 8
C_HEAD_DIM = 64
C_WIDTH = C_HEADS * C_HEAD_DIM
C_QKV_W = 3 * N_C_GROUPS * C_WIDTH
ODD_IN_W = C_QKV_W + C_WIDTH
ATTN_BLOCK = 128
LN_EPS = 1e-5
DEEPNORM_ALPHA = (2 * DEPTH) ** 0.25
DEEPNORM_BETA = (8 * DEPTH) ** -0.25

kernel_name = 'hybrid_rwkv7_shortconv_dilated_swa_step'


def layer_norm(x, g, b):
    xf = x.astype(jnp.float32)
    mu = jnp.mean(xf, -1, keepdims=True)
    var = jnp.mean(jnp.square(xf - mu), -1, keepdims=True)
    return ((xf - mu) * lax.rsqrt(var + LN_EPS) * g + b).astype(x.dtype)


def wkv7_scan(r, decay, k, v, kk, a, s0):
    def step(S, inp):
        r_t, w_t, k_t, v_t, kk_t, a_t = inp
        sa = jnp.einsum('bhij,bhj->bhi', S, -kk_t)
        S = (S * w_t[:, :, None, :] + sa[..., None] * (kk_t * a_t)[:, :, None, :]
             + v_t[..., None] * k_t[:, :, None, :])
        return S, jnp.einsum('bhij,bhj->bhi', S, r_t)
    xs = tuple(jnp.moveaxis(t, 1, 0) for t in (r, decay, k, v, kk, a))
    s_final, ys = lax.scan(step, s0, xs)
    return jnp.moveaxis(ys, 0, 1), s_final


def rwkv7_mix(p, shift_prev, s0, mu, w0, w2, a0, a2, k_k, k_a, r_k, gn_g, gn_b):
    Bn, T, _ = p.shape
    prev = jnp.concatenate([shift_prev[:, None, :], p[:, :-1]], axis=1)
    ps = (p + (prev - p) * mu).astype(jnp.float32)
    r, k, v, wl, al = jnp.split(ps, [A_WIDTH, 2 * A_WIDTH, 3 * A_WIDTH, 3 * A_WIDTH + A_DECAY_RANK], axis=-1)
    w = -jax.nn.softplus(-(w0 + jnp.tanh(wl) @ w2)) - 0.5
    decay = jnp.exp(-jnp.exp(w))
    a = jax.nn.sigmoid(a0 + al @ a2)
    heads = lambda t: t.reshape(Bn, T, A_HEADS, A_HEAD_DIM)
    kk = heads(k * k_k)
    kk = kk * lax.rsqrt(jnp.maximum(jnp.sum(jnp.square(kk), -1, keepdims=True), 1e-24))
    k = k * (1.0 + (a - 1.0) * k_a)
    r, k, v, decay, a = heads(r), heads(k), heads(v), heads(decay), heads(a)
    y, s_new = wkv7_scan(r, decay, k, v, kk, a, s0.astype(jnp.float32))
    mean = jnp.mean(y, -1, keepdims=True)
    var = jnp.mean(jnp.square(y - mean), -1, keepdims=True)
    y = (y - mean) * lax.rsqrt(var + GN_EPS)
    y = y * gn_g.reshape(A_HEADS, A_HEAD_DIM) + gn_b.reshape(A_HEADS, A_HEAD_DIM)
    y = y + jnp.sum(r * k * r_k, -1, keepdims=True) * v
    return y.reshape(Bn, T, A_WIDTH), p[:, -1], s_new


def short_conv_mix(p, conv_prev, conv_w):
    b, c, h = jnp.split(p, 3, axis=-1)
    u = c * h
    T = u.shape[1]
    ucat = jnp.concatenate([conv_prev.astype(u.dtype), u], axis=1)
    y = sum(conv_w[j] * ucat[:, j:j + T] for j in range(CONV_W))
    return b * y, ucat[:, -(CONV_W - 1):]


def even_mix(x, shift_prev, s0, conv_prev, w_in, w_out, rw, conv_w):
    p = x @ w_in
    pA, zA, pB, zB = jnp.split(p, [A_SHIFT_W, A_SHIFT_W + A_WIDTH, A_SHIFT_W + A_WIDTH + 3 * B_WIDTH], axis=-1)
    yA, shift_new, s_new = rwkv7_mix(pA, shift_prev, s0, *rw)
    yB, conv_new = short_conv_mix(pB, conv_prev, conv_w)
    y = jnp.concatenate([yA.astype(x.dtype) * jax.nn.silu(zA), yB * jax.nn.silu(zB)], axis=-1) @ w_out
    return y, shift_new, s_new, conv_new


def dilated_window_attn_prompt(q, k, v, window, dilation):
    Bn, S, H, hd = q.shape
    nj = window // dilation
    L = S // dilation
    nb = -(-L // ATTN_BLOCK)
    Lp = nb * ATTN_BLOCK
    N = Bn * dilation
    def to_sub(t):
        t = t.reshape(Bn, L, dilation, H, hd).transpose(0, 2, 1, 3, 4).reshape(N, L, H, hd)
        return jnp.pad(t, ((0, 0), (0, Lp - L), (0, 0), (0, 0)))
    def band(t):
        tb = jnp.pad(t, ((0, 0), (ATTN_BLOCK, 0), (0, 0), (0, 0))).reshape(N, nb + 1, ATTN_BLOCK, H, hd)
        return jnp.concatenate([tb[:, :-1], tb[:, 1:]], axis=2)
    qb = to_sub(q).reshape(N, nb, ATTN_BLOCK, H, hd)
    kb, vb = band(to_sub(k)), band(to_sub(v))
    s = jnp.einsum('ncqhd,nckhd->nchqk', qb, kb, preferred_element_type=jnp.float32) * (hd ** -0.5)
    qi = jnp.arange(ATTN_BLOCK)[:, None]
    ki = jnp.arange(2 * ATTN_BLOCK)[None, :]
    dist = qi + ATTN_BLOCK - ki
    kpos = (jnp.arange(nb)[:, None, None] - 1) * ATTN_BLOCK + ki[None]
    mask = (dist >= 0) & (dist <= nj) & (kpos >= 0)
    s = jnp.where(mask[None, :, None], s, -jnp.inf)
    m = jnp.max(s, -1, keepdims=True)
    e = jnp.exp(s - m)
    den = jnp.sum(e, -1, keepdims=True)
    o = jnp.einsum('nchqk,nckhd->ncqhd', e / den, vb.astype(jnp.float32))
    lse = (m + jnp.log(den))[..., 0].transpose(0, 1, 3, 2)
    o = o.reshape(N, Lp, H, hd)[:, :L].reshape(Bn, dilation, L, H, hd).transpose(0, 2, 1, 3, 4).reshape(Bn, S, H, hd)
    lse = lse.reshape(N, Lp, H)[:, :L].reshape(Bn, dilation, L, H).transpose(0, 2, 1, 3).reshape(Bn, S, H)
    return o, lse


def dilated_window_attn_sample(q, k, v, kv_buf, window, dilation):
    Bn, T, H, hd = q.shape
    Wb = kv_buf.shape[1]
    nj = window // dilation
    kcat = jnp.concatenate([kv_buf[:, :, 0].astype(k.dtype), k], axis=1)
    vcat = jnp.concatenate([kv_buf[:, :, 1].astype(v.dtype), v], axis=1)
    idx = Wb + jnp.arange(T)[:, None] - dilation * jnp.arange(nj + 1)[None, :]
    valid = idx >= 0
    idxc = jnp.maximum(idx, 0)
    kg, vg = kcat[:, idxc], vcat[:, idxc]
    s = jnp.einsum('bthd,btjhd->bthj', q, kg, preferred_element_type=jnp.float32) * (hd ** -0.5)
    s = jnp.where(valid[None, :, None, :], s, -jnp.inf)
    m = jnp.max(s, -1, keepdims=True)
    e = jnp.exp(s - m)
    den = jnp.sum(e, -1, keepdims=True)
    o = jnp.einsum('bthj,btjhd->bthd', e / den, vg.astype(jnp.float32))
    lse = (m + jnp.log(den))[..., 0]
    keep = min(window, Wb + T)
    new_buf = jnp.stack([kcat, vcat], axis=2)[:, Wb + T - keep:]
    return o, lse, new_buf


def odd_mix(x, kv_bufs, w_in, w_out):
    Bn, T, _ = x.shape
    p = x @ w_in
    qkv = p[..., :C_QKV_W].reshape(Bn, T, 3, N_C_GROUPS, C_HEADS, C_HEAD_DIM)
    z = p[..., C_QKV_W:]
    outs, lses, new_bufs = [], [], []
    for g, (window, dilation) in enumerate(C_GROUPS):
        q, k, v = qkv[:, :, 0, g], qkv[:, :, 1, g], qkv[:, :, 2, g]
        if kv_bufs is None:
            o, lse = dilated_window_attn_prompt(q, k, v, window, dilation)
            keep = min(window, T)
            nbuf = jnp.stack([k, v], axis=2)[:, T - keep:]
        else:
            o, lse, nbuf = dilated_window_attn_sample(q, k, v, kv_bufs[g], window, dilation)
        outs.append(o)
        lses.append(lse)
        new_bufs.append(nbuf)
    alpha = jax.nn.softmax(jnp.stack(lses, axis=2), axis=2)
    o = jnp.sum(alpha[..., None] * jnp.stack(outs, axis=2), axis=2)
    y = o.reshape(Bn, T, C_WIDTH).astype(x.dtype) * jax.nn.silu(z)
    return y @ w_out, new_bufs


def setup_inputs(seed: int = 0) -> dict:
    key = jax.random.key(seed)
    ks = jax.random.split(key, 32)
    nrm = lambda k, shape, s: jax.random.normal(k, shape, jnp.float32) * s
    kv_shape = lambda w: (N_ODD, DEC_BATCH, min(w, PAST_LEN), 2, C_HEADS, C_HEAD_DIM)
    return {
        'x_prompt': nrm(ks[0], (BATCH, SEQ, D_MODEL), 1.0),
        'x_sample': nrm(ks[1], (DEC_BATCH, DEC_SEQ, D_MODEL), 1.0),
        'state_rwkv': nrm(ks[2], (N_EVEN, DEC_BATCH, A_HEADS, A_HEAD_DIM, A_HEAD_DIM), 0.1),
        'state_shift': nrm(ks[3], (N_EVEN, DEC_BATCH, A_SHIFT_W), 1.0),
        'state_conv': nrm(ks[4], (N_EVEN, DEC_BATCH, CONV_W - 1, B_WIDTH), 1.0),
        'cache_kv_w128': nrm(ks[5], kv_shape(128), 1.0),
        'cache_kv_w512': nrm(ks[6], kv_shape(512), 1.0),
        'cache_kv_w2048': nrm(ks[7], kv_shape(2048), 1.0),
        'even_w_in': nrm(ks[8], (N_EVEN, D_MODEL, EVEN_IN_W), D_MODEL ** -0.5),
        'even_w_out': nrm(ks[9], (N_EVEN, EVEN_MIX_W, D_MODEL), EVEN_MIX_W ** -0.5 * DEEPNORM_BETA),
        'rwkv_mu': jax.random.uniform(ks[10], (N_EVEN, A_SHIFT_W), jnp.float32),
        'rwkv_w0': -1.0 + nrm(ks[11], (N_EVEN, A_WIDTH), 0.5),
        'rwkv_w2': nrm(ks[12], (N_EVEN, A_DECAY_RANK, A_WIDTH), 0.1),
        'rwkv_a0': nrm(ks[13], (N_EVEN, A_WIDTH), 0.1),
        'rwkv_a2': nrm(ks[14], (N_EVEN, A_ICLR_RANK, A_WIDTH), 0.1),
        'rwkv_k_k': 0.85 + nrm(ks[15], (N_EVEN, A_WIDTH), 0.02),
        'rwkv_k_a': 1.0 + nrm(ks[16], (N_EVEN, A_WIDTH), 0.02),
        'rwkv_r_k': nrm(ks[17], (N_EVEN, A_HEADS, A_HEAD_DIM), 0.1),
        'rwkv_gn_g': 1.0 + nrm(ks[18], (N_EVEN, A_WIDTH), 0.02),
        'rwkv_gn_b': nrm(ks[19], (N_EVEN, A_WIDTH), 0.02),
        'conv_w': nrm(ks[20], (N_EVEN, CONV_W, B_WIDTH), CONV_W ** -0.5),
        'odd_w_in': nrm(ks[21], (N_ODD, D_MODEL, ODD_IN_W), D_MODEL ** -0.5),
        'odd_w_out': nrm(ks[22], (N_ODD, C_WIDTH, D_MODEL), C_WIDTH ** -0.5 * DEEPNORM_BETA),
        'ln_g': 1.0 + nrm(ks[23], (DEPTH, D_MODEL), 0.02),
        'ln_b': nrm(ks[24], (DEPTH, D_MODEL), 0.02),
    }


def reference(x_prompt, x_sample, state_rwkv, state_shift, state_conv, cache_kv_w128, cache_kv_w512,
              cache_kv_w2048, even_w_in, even_w_out, rwkv_mu, rwkv_w0, rwkv_w2, rwkv_a0, rwkv_a2,
              rwkv_k_k, rwkv_k_a, rwkv_r_k, rwkv_gn_g, rwkv_gn_b, conv_w, odd_w_in, odd_w_out, ln_g, ln_b):
    xp, xs = x_prompt, x_sample
    Bp = xp.shape[0]
    caches = (cache_kv_w128, cache_kv_w512, cache_kv_w2048)
    rwkv_p, rwkv_s, shift_p, shift_s, conv_p, conv_s = [], [], [], [], [], []
    kv_p = [[] for _ in range(N_C_GROUPS)]
    kv_s = [[] for _ in range(N_C_GROUPS)]
    for li in range(DEPTH):
        j = li // 2
        if li % 2 == 0:
            rw = (rwkv_mu[j], rwkv_w0[j], rwkv_w2[j], rwkv_a0[j], rwkv_a2[j], rwkv_k_k[j],
                  rwkv_k_a[j], rwkv_r_k[j], rwkv_gn_g[j], rwkv_gn_b[j])
            yp, sh_new, s_new, cv_new = even_mix(
                xp, jnp.zeros((Bp, A_SHIFT_W), xp.dtype),
                jnp.zeros((Bp, A_HEADS, A_HEAD_DIM, A_HEAD_DIM), jnp.float32),
                jnp.zeros((Bp, CONV_W - 1, B_WIDTH), xp.dtype),
                even_w_in[j], even_w_out[j], rw, conv_w[j])
            rwkv_p.append(s_new); shift_p.append(sh_new); conv_p.append(cv_new)
            ys, sh_new, s_new, cv_new = even_mix(
                xs, state_shift[j], state_rwkv[j], state_conv[j],
                even_w_in[j], even_w_out[j], rw, conv_w[j])
            rwkv_s.append(s_new); shift_s.append(sh_new); conv_s.append(cv_new)
        else:
            yp, bufs_p = odd_mix(xp, None, odd_w_in[j], odd_w_out[j])
            ys, bufs_s = odd_mix(xs, tuple(c[j] for c in caches), odd_w_in[j], odd_w_out[j])
            for g in range(N_C_GROUPS):
                kv_p[g].append(bufs_p[g])
                kv_s[g].append(bufs_s[g])
        xp = layer_norm(DEEPNORM_ALPHA * xp + yp, ln_g[li], ln_b[li])
        xs = layer_norm(DEEPNORM_ALPHA * xs + ys, ln_g[li], ln_b[li])
    return (xp, xs,
            jnp.stack(rwkv_p), jnp.stack(rwkv_s),
            jnp.stack(shift_p), jnp.stack(shift_s),
            jnp.stack(conv_p), jnp.stack(conv_s),
            jnp.stack(kv_p[0]), jnp.stack(kv_s[0]),
            jnp.stack(kv_p[1]), jnp.stack(kv_s[1]),
            jnp.stack(kv_p[2]), jnp.stack(kv_s[2]))
```

```cpp
#include <hip/hip_runtime.h>
#include <hip/hip_cooperative_groups.h>
#include <cstdio>
#include <cstdint>
namespace cg = cooperative_groups;
__device__ __forceinline__ int pg8_opaque_lane() { unsigned m = ~0u; asm volatile("" : "+s"(m)); return (int)__builtin_amdgcn_mbcnt_hi(m, __builtin_amdgcn_mbcnt_lo(m, 0u)); }
namespace pg8 {
#define PG8_LAS __attribute__((address_space(3)))
typedef unsigned short bf16_t;
typedef short bf16x8 __attribute__((ext_vector_type(8)));
typedef float f32x4 __attribute__((ext_vector_type(4)));
typedef unsigned u32x4 __attribute__((ext_vector_type(4)));
constexpr int BM = 256, BK = 64, HALF = 128, HTB = HALF * BK * 2  , STAGE_BYTES = 8 * HTB, NXCD = 8, WGM = 8;

__host__ __device__ __forceinline__ int lds_byte(int r, int c) { const int st = (r >> 4) * 2 + (c >> 5), rr = r & 15, cc = c & 31, ob = rr * 64 + cc * 2; return st * 1024 + (ob ^ (((ob >> 9) & 1) << 5)); }
__host__ __device__ __forceinline__ void stage_rc(int b, int& R, int& C) { const int st = b / 1024, sb = b % 1024, swz = sb ^ (((sb >> 9) & 1) << 5); R = (st >> 1) * 16 + swz / 64; C = (st & 1) * 32 + (swz % 64) / 2; }
__host__ __device__ __forceinline__ int perm32(int rho) { const int n = rho >> 4, i = rho & 15; return 8 * (i >> 2) + 4 * n + (i & 3); }

struct Unit { int pm, pn; };
struct Gemm { const bf16_t* A; const bf16_t* Bt; int M, N, K; };

struct StaticOrder {
    int nM, nN, nwg, G, c;
    __host__ __device__ void init(int M, int N, int G_, int c_) { nM = M / BM; nN = N / BM; nwg = nM * nN; G = G_; c = c_; }
    __host__ __device__ bool next(int i, Unit& u) const {
        const long L = (long)i * G + c; if (L >= nwg) return false;
        int wgid = (int)L; { const int q = nwg / NXCD, r = nwg % NXCD, xcd = wgid % NXCD, off = wgid / NXCD; wgid = (xcd < r ? xcd * (q + 1) : r * (q + 1) + (xcd - r) * q) + off; }
        const int nig = WGM * nN, gid = wgid / nig, fm = gid * WGM, gsz = (nM - fm) < WGM ? (nM - fm) : WGM;
        u.pm = fm + ((wgid % nig) % gsz); u.pn = (wgid % nig) / gsz; return true;
    }
    __device__ __forceinline__ void a_ready(const Unit&) const {}
    __device__ __forceinline__ void done(const Unit&) const {}
};

__device__ __forceinline__ unsigned cvt_pk_bf16(float lo, float hi) { unsigned r; asm volatile("v_cvt_pk_bf16_f32 %0, %1, %2" : "=v"(r) : "v"(lo), "v"(hi)); return r; }
typedef float f32x2 __attribute__((ext_vector_type(2)));
template <class Epi, class Sched, bool ALIGN_EPI = false, bool SP2 = false>
__device__ __forceinline__ void gemm_phase(PG8_LAS unsigned char* lds, const Gemm g, const Sched& S, const Epi& E, const int wave_s) {
    int wid_ = wave_s; asm volatile("" : "+s"(wid_));
    const int lane = pg8_opaque_lane(), wid = wid_, tid = wid_ * 64 + lane, wr = wid >> 2, wc = wid & 3, fr = lane & 15, fq = lane >> 4;
    const int K = g.K, nt = K / BK;
    unsigned voffA[2], voffB[2];
#pragma unroll
    for (int i = 0; i < 2; ++i) { int R, C; stage_rc(tid * 16 + i * 8192, R, C); const int Rb = Epi::PERM ? ((R & ~31) + perm32(R & 31)) : R;
        voffA[i] = (unsigned)(R * K + C) * 2u; voffB[i] = (unsigned)(Rb * K + C) * 2u; }
    const size_t kstep = (size_t)(BK * 2);
    const size_t hstep = (size_t)HALF * K * 2;
    const size_t tstep = 2 * hstep;
    const unsigned ldsw = (unsigned)wid * 1024u;
    const int aoff = lds_byte(wr * 64 + fr, fq * 8), boff = lds_byte(wc * 32 + fr, fq * 8);
#define PG8_SA(b, h) (((b) * 2 + (h)) * HTB)
#define PG8_SB(b, h) ((4 + (b) * 2 + (h)) * HTB)
#define PG8_STAGE(bufoff, gbase, voff) do { _Pragma("unroll") for (int _i = 0; _i < 2; ++_i) \
        __builtin_amdgcn_global_load_lds((const unsigned*)((const char*)(gbase) + (voff)[_i]), (PG8_LAS unsigned*)(lds + (bufoff) + ldsw + _i * 8192), 16, 0, 0); } while (0)
#define PG8_LDA(dst, b, h) do { _Pragma("unroll") for (int m = 0; m < 4; ++m) _Pragma("unroll") for (int k = 0; k < 2; ++k) dst[m][k] = *(const PG8_LAS bf16x8*)(lds + PG8_SA(b, h) + aoff + m * 2048 + k * 1024); } while (0)
#define PG8_LDB(dst, b, h) do { _Pragma("unroll") for (int n = 0; n < 2; ++n) _Pragma("unroll") for (int k = 0; k < 2; ++k) dst[n][k] = *(const PG8_LAS bf16x8*)(lds + PG8_SB(b, h) + boff + n * 2048 + k * 1024); } while (0)
#define PG8_MMA(ai, bj, At, Bt) do { __builtin_amdgcn_s_setprio(1); _Pragma("unroll") for (int m = 0; m < 4; ++m) _Pragma("unroll") for (int n = 0; n < 2; ++n) _Pragma("unroll") for (int k = 0; k < 2; ++k) \
        acc[ai][bj][m][n] = __builtin_amdgcn_mfma_f32_16x16x32_bf16(Bt[n][k], At[m][k], acc[ai][bj][m][n], 0, 0, 0); __builtin_amdgcn_s_setprio(0); } while (0)
#define PG8_WAIT_V(n) asm volatile("s_waitcnt vmcnt(" #n ")" ::: "memory")
#define PG8_WAIT_L(n) asm volatile("s_waitcnt lgkmcnt(" #n ")" ::: "memory")
#define PG8_BAR __builtin_amdgcn_s_barrier()
#define PG8_SCHED __builtin_amdgcn_sched_barrier(0)
    Unit cur, nxt; int ui = 0;
    if (!S.next(0, cur)) return;
    f32x4 acc[2][2][4][2];
#pragma unroll
    for (int a = 0; a < 2; ++a)
#pragma unroll
        for (int b = 0; b < 2; ++b)
#pragma unroll
            for (int m = 0; m < 4; ++m)
#pragma unroll
                for (int n = 0; n < 2; ++n) acc[a][b][m][n] = (f32x4){0.f, 0.f, 0.f, 0.f};
    bf16x8 At[4][2], B0[2][2], B1[2][2];
    const char* cA = (const char*)g.A + (size_t)cur.pm * tstep; const char* cB = (const char*)g.Bt + (size_t)cur.pn * tstep;
    S.a_ready(cur);
    if constexpr (SP2) {
        PG8_STAGE(PG8_SB(0, 0), cB, voffB); PG8_STAGE(PG8_SB(0, 1), cB + hstep, voffB); PG8_STAGE(PG8_SA(0, 0), cA, voffA); PG8_STAGE(PG8_SA(0, 1), cA + hstep, voffA);
        if (wr == 1) PG8_BAR;
        PG8_WAIT_V(2); PG8_BAR;
        PG8_STAGE(PG8_SB(1, 0), cB + kstep, voffB); PG8_STAGE(PG8_SA(1, 0), cA + kstep, voffA); PG8_STAGE(PG8_SB(1, 1), cB + hstep + kstep, voffB);
        PG8_WAIT_V(6); PG8_BAR;
    } else {
        PG8_STAGE(PG8_SB(0, 0), cB, voffB); PG8_STAGE(PG8_SA(0, 0), cA, voffA); PG8_STAGE(PG8_SB(0, 1), cB + hstep, voffB); PG8_STAGE(PG8_SA(0, 1), cA + hstep, voffA);
        if (wr == 1) PG8_BAR;
        PG8_WAIT_V(4); PG8_BAR;
        PG8_STAGE(PG8_SB(1, 0), cB + kstep, voffB); PG8_STAGE(PG8_SA(1, 0), cA + kstep, voffA); PG8_STAGE(PG8_SB(1, 1), cB + hstep + kstep, voffB);
        PG8_WAIT_V(6); PG8_BAR;
    }
    for (;;) {
        const bool has_next = S.next(ui + 1, nxt);
        const char* nA = has_next ? (const char*)g.A + (size_t)nxt.pm * tstep : cA; const char* nB = has_next ? (const char*)g.Bt + (size_t)nxt.pn * tstep : cB;
        for (int t = 0; t < nt; t += 2) {
            const bool last = (t == nt - 2);
            const char* a1 = cA + (size_t)(t + 1) * kstep;
            const char* a2 = last ? nA : cA + (size_t)(t + 2) * kstep; const char* b2 = last ? nB : cB + (size_t)(t + 2) * kstep;
            const char* a3 = a2 + kstep; const char* b3 = b2 + kstep;
            if (last && has_next) S.a_ready(nxt);
            if constexpr (SP2) {
            PG8_LDB(B0, 0, 0); PG8_LDB(B1, 0, 1); PG8_SCHED; PG8_LDA(At, 0, 0); PG8_STAGE(PG8_SA(1, 1), a1 + hstep, voffA);
            PG8_WAIT_V(8); PG8_WAIT_L(0); PG8_BAR; PG8_MMA(0, 0, At, B0); PG8_MMA(0, 1, At, B1); PG8_BAR; PG8_SCHED;
            PG8_LDA(At, 0, 1); PG8_STAGE(PG8_SB(0, 0), b2, voffB); PG8_STAGE(PG8_SB(0, 1), b2 + hstep, voffB); PG8_STAGE(PG8_SA(0, 0), a2, voffA);
            PG8_WAIT_V(8); PG8_WAIT_L(0); PG8_BAR; PG8_MMA(1, 0, At, B0); PG8_MMA(1, 1, At, B1); PG8_BAR; PG8_SCHED;
            PG8_LDB(B0, 1, 0); PG8_LDB(B1, 1, 1); PG8_SCHED; PG8_LDA(At, 1, 0); PG8_STAGE(PG8_SA(0, 1), a2 + hstep, voffA);
            PG8_WAIT_V(8); PG8_WAIT_L(0); PG8_BAR; PG8_MMA(0, 0, At, B0); PG8_MMA(0, 1, At, B1); PG8_BAR; PG8_SCHED;
            PG8_LDA(At, 1, 1); PG8_STAGE(PG8_SB(1, 0), b3, voffB); PG8_STAGE(PG8_SB(1, 1), b3 + hstep, voffB); PG8_STAGE(PG8_SA(1, 0), a3, voffA);
            PG8_WAIT_V(8); PG8_WAIT_L(0); PG8_BAR; PG8_MMA(1, 0, At, B0); PG8_MMA(1, 1, At, B1); PG8_BAR; PG8_SCHED;
            } else {
            PG8_LDB(B0, 0, 0); PG8_SCHED; PG8_LDA(At, 0, 0); PG8_STAGE(PG8_SA(1, 1), a1 + hstep, voffA);
            PG8_WAIT_L(8); PG8_BAR; PG8_WAIT_L(0); PG8_MMA(0, 0, At, B0); PG8_BAR; PG8_SCHED;
            PG8_LDB(B1, 0, 1); PG8_STAGE(PG8_SB(0, 0), b2, voffB);
            PG8_BAR; PG8_WAIT_L(0); PG8_MMA(0, 1, At, B1); PG8_BAR;
            PG8_LDA(At, 0, 1); PG8_STAGE(PG8_SA(0, 0), a2, voffA);
            PG8_BAR; PG8_WAIT_L(0); PG8_MMA(1, 0, At, B0); PG8_BAR; PG8_SCHED;
            PG8_STAGE(PG8_SB(0, 1), b2 + hstep, voffB);
            PG8_WAIT_V(6); PG8_BAR; PG8_MMA(1, 1, At, B1); PG8_BAR;
            PG8_LDB(B0, 1, 0); PG8_SCHED; PG8_LDA(At, 1, 0); PG8_STAGE(PG8_SA(0, 1), a2 + hstep, voffA);
            PG8_WAIT_L(8); PG8_BAR; PG8_WAIT_L(0); PG8_MMA(0, 0, At, B0); PG8_BAR; PG8_SCHED;
            PG8_LDB(B1, 1, 1); PG8_STAGE(PG8_SB(1, 0), b3, voffB);
            PG8_BAR; PG8_WAIT_L(0); PG8_MMA(0, 1, At, B1); PG8_BAR;
            PG8_LDA(At, 1, 1); PG8_STAGE(PG8_SA(1, 0), a3, voffA);
            PG8_BAR; PG8_WAIT_L(0); PG8_MMA(1, 0, At, B0); PG8_BAR; PG8_SCHED;
            PG8_STAGE(PG8_SB(1, 1), b3 + hstep, voffB);
            PG8_WAIT_V(6); PG8_BAR; PG8_MMA(1, 1, At, B1); PG8_BAR;
            }
        }
        if constexpr (ALIGN_EPI) { if (wr == 0) PG8_BAR; }
        if constexpr (!Epi::AFTER_DRAIN) { E(acc, cur, wr, wc, fr, fq); S.done(cur); }
        if (!has_next) break;
#pragma unroll
        for (int a = 0; a < 2; ++a)
#pragma unroll
            for (int b = 0; b < 2; ++b)
#pragma unroll
                for (int m = 0; m < 4; ++m)
#pragma unroll
                    for (int n = 0; n < 2; ++n) acc[a][b][m][n] = (f32x4){0.f, 0.f, 0.f, 0.f};
        cur = nxt; cA = nA; cB = nB; ++ui;
        if constexpr (ALIGN_EPI) { if (wr == 1) PG8_BAR; }
    }
    PG8_WAIT_V(0);
    if constexpr (!ALIGN_EPI) { if (wr == 0) PG8_BAR; }
    PG8_BAR;
    if constexpr (Epi::AFTER_DRAIN) { E.fused(acc, cur, wr, wc, fr, fq, lds, wid, lane); S.done(cur); }
#undef PG8_SA
#undef PG8_SB
#undef PG8_STAGE
#undef PG8_LDA
#undef PG8_LDB
#undef PG8_MMA
#undef PG8_WAIT_V
#undef PG8_WAIT_L
#undef PG8_BAR
#undef PG8_SCHED
}
}

#define LAS __attribute__((address_space(3)))
#define CAS __attribute__((address_space(4)))
typedef unsigned short bf16_t;
typedef float f32x4 __attribute__((ext_vector_type(4)));
typedef float f32x2 __attribute__((ext_vector_type(2)));
typedef unsigned u32x4 __attribute__((ext_vector_type(4)));
typedef unsigned u32x2 __attribute__((ext_vector_type(2)));
typedef short bf16x8 __attribute__((ext_vector_type(8)));
typedef CAS const float cfloat;

constexpr int DM = 1024, NP = 16384, NS = 256, MTOK = NP + NS;
constexpr int SEQ = 2048, PB = 8, SB = 32, ST = 8;
constexpr int EIN = 4224, EINP = 4352, OIN = 5120, ASW = 1664;
constexpr int CH = 64, NCH = SEQ / CH, TS = 4;
constexpr float ALPHA = 1.6817928305074292f;

constexpr size_t O_Y = 0;
constexpr size_t O_RWKV_P = (size_t)MTOK * DM;
constexpr size_t O_RWKV_S = O_RWKV_P + 2ull * 8 * 8 * 4096;
constexpr size_t O_SH_P = O_RWKV_S + 2ull * 32 * 8 * 4096;
constexpr size_t O_SH_S = O_SH_P + 2ull * 8 * ASW;
constexpr size_t O_CV_P = O_SH_S + 2ull * 32 * ASW;
constexpr size_t O_CV_S = O_CV_P + 2ull * 8 * 2 * 512;
constexpr size_t O_KV128_P = O_CV_S + 2ull * 32 * 2 * 512;
constexpr size_t O_KV128_S = O_KV128_P + 2ull * 8 * 128 * 1024;
constexpr size_t O_KV512_P = O_KV128_S + 2ull * 32 * 128 * 1024;
constexpr size_t O_KV512_S = O_KV512_P + 2ull * 8 * 512 * 1024;
constexpr size_t O_KV2048_P = O_KV512_S + 2ull * 32 * 512 * 1024;
constexpr size_t O_KV2048_S = O_KV2048_P + 2ull * 8 * 2048 * 1024;
constexpr size_t O_END = O_KV2048_S + 2ull * 32 * 2048 * 1024;
static_assert(O_END == 240076800ull, "output size");

constexpr size_t MiB = 1ull << 20;
constexpr size_t WS_WEI = 0;
constexpr size_t WS_WEO = WS_WEI + 2ull * EINP * 1024 * 2;
constexpr size_t WS_WOI = WS_WEO + 2ull * 1024 * 1024 * 2;
constexpr size_t WS_WOO = WS_WOI + 2ull * OIN * 1024 * 2;
constexpr size_t WS_XF = 64 * MiB;
constexpr size_t WS_XB = WS_XF + 66 * MiB;
constexpr size_t WS_P = WS_XB + 34 * MiB;
constexpr size_t WS_Z = WS_P + 164 * MiB;
constexpr size_t WS_MIX = WS_Z + 66 * MiB;
constexpr size_t WS_SC = WS_MIX + 34 * MiB;
constexpr size_t SC_STRIDE = (size_t)MTOK * 512 * 4;
constexpr size_t WS_Q = WS_SC + 6 * SC_STRIDE;
constexpr size_t SET_STRIDE = 7 * SC_STRIDE;
constexpr size_t WS_BON = WS_SC + 2 * SET_STRIDE + MiB;
constexpr size_t WS_YL = WS_BON + MiB;
constexpr size_t WS_LC = WS_YL + 34 * MiB;
constexpr size_t WS_PC = WS_LC + 34 * MiB;
constexpr size_t WS_SST = WS_PC + 34 * MiB;
constexpr size_t WS_OG = WS_SST + 34 * MiB;
constexpr size_t WS_LSE = WS_OG + 49 * MiB;
constexpr size_t WS_CTL = WS_LSE + 2 * MiB;
constexpr size_t WS_END = WS_CTL + MiB;

constexpr int LDS_BYTES = 147456, MISC_OFF = 131072 + 320;

struct Params { const float* in[25]; float* out; unsigned char* ws; };

__device__ __forceinline__ float bf2f(bf16_t h) { return __uint_as_float(((unsigned)h) << 16); }
__device__ __forceinline__ unsigned f2bf(float f) { unsigned u = __float_as_uint(f); return (u + 0x7fffu + ((u >> 16) & 1u)) >> 16; }
__device__ __forceinline__ unsigned pk2(float lo, float hi) { return f2bf(lo) | (f2bf(hi) << 16); }
__device__ __forceinline__ float wave_sum(float v) {
#define DPPADD_(ctrl, rm, bc) v += __builtin_bit_cast(float, __builtin_amdgcn_update_dpp(0, __builtin_bit_cast(int, v), ctrl, rm, 0xf, bc))
    DPPADD_(0x111, 0xf, true); DPPADD_(0x112, 0xf, true); DPPADD_(0x114, 0xf, true); DPPADD_(0x118, 0xf, true);
    DPPADD_(0x142, 0xa, false); DPPADD_(0x143, 0xc, false);
#undef DPPADD_
    return __builtin_bit_cast(float, __builtin_amdgcn_readlane(__builtin_bit_cast(int, v), 63));
}
__device__ __forceinline__ float row16_sum(float v) {
#define ROR_(n) v += __builtin_bit_cast(float, __builtin_amdgcn_update_dpp(0, __builtin_bit_cast(int, v), 0x120 + n, 0xf, 0xf, false))
    ROR_(8); ROR_(4); ROR_(2); ROR_(1);
#undef ROR_
    return v;
}
__device__ __forceinline__ void swap16_(float& a, float& b) { asm volatile("s_nop 1\n\tv_permlane16_swap_b32 %0, %1" : "+v"(a), "+v"(b)); }
__device__ __forceinline__ void swap32_(float& a, float& b) { asm volatile("s_nop 1\n\tv_permlane32_swap_b32 %0, %1" : "+v"(a), "+v"(b)); }
__device__ __forceinline__ float xsum4(float a) {
    float p = a, q = a; swap16_(p, q); float s = p + q;
    float u = s, w = s; swap32_(u, w); return u + w;
}
__device__ __forceinline__ float xmax4(float a) {
    float p = a, q = a; swap16_(p, q); float s = fmaxf(p, q);
    float u = s, w = s; swap32_(u, w); return fmaxf(u, w);
}
__device__ __forceinline__ float wave_max(float v) {
#define DPPMAX_(ctrl, rm) v = fmaxf(v, __builtin_bit_cast(float, __builtin_amdgcn_update_dpp(__builtin_bit_cast(int, v), __builtin_bit_cast(int, v), ctrl, rm, 0xf, false)))
    DPPMAX_(0x111, 0xf); DPPMAX_(0x112, 0xf); DPPMAX_(0x114, 0xf); DPPMAX_(0x118, 0xf); DPPMAX_(0x142, 0xa); DPPMAX_(0x143, 0xc);
#undef DPPMAX_
    return __builtin_bit_cast(float, __builtin_amdgcn_readlane(__builtin_bit_cast(int, v), 63));
}
__device__ __forceinline__ float silu(float x) { return x / (1.f + __expf(-x)); }
__device__ __forceinline__ float sigmoidf(float x) { return 1.f / (1.f + __expf(-x)); }

__device__ __forceinline__ float fma_s(float a, float b, float c) { float d; asm("v_fma_f32 %0, %1, %2, %3" : "=v"(d) : "v"(a), "v"(b), "v"(c)); return d; }
__device__ __forceinline__ float fnma_s(float a, float b, float c) { float d; asm("v_fma_f32 %0, -%1, %2, %3" : "=v"(d) : "v"(a), "v"(b), "v"(c)); return d; }
__device__ __forceinline__ float mul_s(float a, float b) { float d; asm("v_mul_f32 %0, %1, %2" : "=v"(d) : "v"(a), "v"(b)); return d; }

namespace pg8 {
struct EpiStoreBf16 {
    static constexpr bool PERM = true, AFTER_DRAIN = false;
    bf16_t* O; int ldc;
    __device__ __forceinline__ void operator()(const f32x4 (&acc)[2][2][4][2], const Unit& u, int wr, int wc, int fr, int fq) const {
        const int row0 = u.pm * BM + wr * 64 + fr, col0 = u.pn * BM + wc * 32 + 8 * fq;
#pragma unroll
        for (int ai = 0; ai < 2; ++ai)
#pragma unroll
            for (int m = 0; m < 4; ++m) { bf16_t* rowp = O + (size_t)(row0 + ai * HALF + m * 16) * ldc + col0;
#pragma unroll
                for (int bj = 0; bj < 2; ++bj) { const f32x4 v0 = acc[ai][bj][m][0], v1 = acc[ai][bj][m][1];
                    u32x4 w; w.x = cvt_pk_bf16(v0[0], v0[1]); w.y = cvt_pk_bf16(v0[2], v0[3]); w.z = cvt_pk_bf16(v1[0], v1[1]); w.w = cvt_pk_bf16(v1[2], v1[3]);
                    *(u32x4*)(rowp + bj * HALF) = w; } }
    }
};
struct EpiOddIn {
    static constexpr bool PERM = true, AFTER_DRAIN = false;
    bf16_t* O; float* out; int j;
    __device__ __forceinline__ void operator()(const f32x4 (&acc)[2][2][4][2], const Unit& u, int wr, int wc, int fr, int fq) const {
        const int row0 = u.pm * BM + wr * 64 + fr, colt = u.pn * BM, col0 = colt + wc * 32 + 8 * fq;
        const int type = colt / 1536, rem = colt - type * 1536, g = rem >> 9, cbase = (rem & 511) + wc * 32 + 8 * fq;
        const int W = g == 0 ? 128 : (g == 1 ? 512 : 2048);
        const size_t offp = (g == 0 ? O_KV128_P : (g == 1 ? O_KV512_P : O_KV2048_P)) + (size_t)j * PB * W * 1024;
        const size_t offs = (g == 0 ? O_KV128_S : (g == 1 ? O_KV512_S : O_KV2048_S)) + (size_t)j * SB * W * 1024;
        const bool iskv = (type == 1 || type == 2);
#pragma unroll
        for (int ai = 0; ai < 2; ++ai)
#pragma unroll
            for (int m = 0; m < 4; ++m) { const int row = row0 + ai * HALF + m * 16; bf16_t* rowp = O + (size_t)row * OIN + col0;
                bool wr_kv = false; size_t doff = 0;
                if (iskv) {
                    if (row < NP) { const int b = row >> 11, t = row & 2047, r = t - (SEQ - W); if (r >= 0) { wr_kv = true; doff = offp + ((size_t)(b * W + r) * 2 + (type - 1)) * 512 + cbase; } }
                    else { const int s = row - NP, b = s >> 3, t = s & 7, r = W - 8 + t; wr_kv = true; doff = offs + ((size_t)(b * W + r) * 2 + (type - 1)) * 512 + cbase; }
                }
#pragma unroll
                for (int bj = 0; bj < 2; ++bj) { const f32x4 v0 = acc[ai][bj][m][0], v1 = acc[ai][bj][m][1];
                    u32x4 w; w.x = cvt_pk_bf16(v0[0], v0[1]); w.y = cvt_pk_bf16(v0[2], v0[3]); w.z = cvt_pk_bf16(v1[0], v1[1]); w.w = cvt_pk_bf16(v1[2], v1[3]);
                    *(u32x4*)(rowp + bj * HALF) = w;
                    if (wr_kv) { *(f32x4*)(out + doff + bj * HALF) = v0; *(f32x4*)(out + doff + bj * HALF + 4) = v1; } } }
    }
};
struct EpiResid {
    static constexpr bool PERM = false, AFTER_DRAIN = false;
    const float* X; float* Z;
    __device__ __forceinline__ void operator()(const f32x4 (&acc)[2][2][4][2], const Unit& u, int wr, int wc, int fr, int fq) const {
        const int row0 = u.pm * BM + wr * 64 + fr, col0 = u.pn * BM + wc * 32 + 4 * fq;
#pragma unroll
        for (int ai = 0; ai < 2; ++ai)
#pragma unroll
            for (int m = 0; m < 4; ++m) { const size_t off = (size_t)(row0 + ai * HALF + m * 16) * DM + col0;
#pragma unroll
                for (int bj = 0; bj < 2; ++bj)
#pragma unroll
                    for (int n = 0; n < 2; ++n) { const f32x4 x = *(const f32x4*)(X + off + bj * HALF + n * 16);
                        *(f32x4*)(Z + off + bj * HALF + n * 16) = x * ALPHA + acc[ai][bj][m][n]; } }
    }
};
}

__device__ __forceinline__ void p0_transpose_item(const float* W, int K, int N, bf16_t* WT, LAS float* scr, int item, int lane) {
    const int nblk = N / 32, kb = item / nblk, nb = item % nblk, k0 = 64 * kb, n0 = 32 * nb;
    float tv[32];
#pragma unroll
    for (int i = 0; i < 32; ++i) tv[i] = W[(size_t)(k0 + 2 * i + (lane >> 5)) * N + n0 + (lane & 31)];
#pragma unroll
    for (int i = 0; i < 32; ++i) scr[(2 * i + (lane >> 5)) * 33 + (lane & 31)] = tv[i];
    asm volatile("s_waitcnt lgkmcnt(0)" ::: "memory");
    const int c = lane & 7;
#pragma unroll
    for (int j = 0; j < 4; ++j) { const int n = (lane >> 3) + 8 * j; const LAS float* s = scr + (8 * c) * 33 + n;
        u32x4 o; o.x = pk2(s[0 * 33], s[1 * 33]); o.y = pk2(s[2 * 33], s[3 * 33]); o.z = pk2(s[4 * 33], s[5 * 33]); o.w = pk2(s[6 * 33], s[7 * 33]);
        *(u32x4*)(WT + (size_t)(n0 + n) * K + k0 + 8 * c) = o; }
    asm volatile("s_waitcnt lgkmcnt(0)" ::: "memory");
}

__device__ __forceinline__ void phase0(const Params& p, LAS unsigned char* lds, int gw, int NGW, int wave, int lane) {
    LAS float* scr = (LAS float*)(lds + wave * 16384);
    unsigned char* ws = p.ws;
    constexpr int I_EI = (1024 / 64) * (EIN / 32), I_EO = (1024 / 64) * (1024 / 32), I_OI = (1024 / 64) * (OIN / 32), I_OO = (512 / 64) * (1024 / 32);
    constexpr int NIT = 2 * (I_EI + I_EO + I_OI + I_OO);
    for (int it = gw; it < NIT; it += NGW) {
        int r = it;
        if (r < 2 * I_EI) { const int j = r / I_EI; p0_transpose_item(p.in[8] + (size_t)j * 1024 * EIN, 1024, EIN, (bf16_t*)(ws + WS_WEI) + (size_t)j * EINP * 1024, scr, r % I_EI, lane); continue; } r -= 2 * I_EI;
        if (r < 2 * I_EO) { const int j = r / I_EO; p0_transpose_item(p.in[9] + (size_t)j * 1024 * 1024, 1024, 1024, (bf16_t*)(ws + WS_WEO) + (size_t)j * 1024 * 1024, scr, r % I_EO, lane); continue; } r -= 2 * I_EO;
        if (r < 2 * I_OI) { const int j = r / I_OI; p0_transpose_item(p.in[21] + (size_t)j * 1024 * OIN, 1024, OIN, (bf16_t*)(ws + WS_WOI) + (size_t)j * OIN * 1024, scr, r % I_OI, lane); continue; } r -= 2 * I_OI;
        { const int j = r / I_OO; p0_transpose_item(p.in[22] + (size_t)j * 512 * 1024, 512, 1024, (bf16_t*)(ws + WS_WOO) + (size_t)j * 1024 * 512, scr, r % I_OO, lane); }
    }
    for (int i = gw * 64 + lane; i < 2 * 16384; i += NGW * 64) { const int j = i >> 14, o = i & 16383;
        *((u32x4*)((bf16_t*)(ws + WS_WEI) + (size_t)j * EINP * 1024 + (size_t)EIN * 1024) + o) = (u32x4){0u, 0u, 0u, 0u}; }
    bf16_t* Xb = (bf16_t*)(ws + WS_XB);
    for (size_t i0 = (size_t)gw * 256 + lane; i0 < (size_t)MTOK * 256; i0 += (size_t)NGW * 256) {
        f32x4 v[4];
#pragma unroll
        for (int u = 0; u < 4; ++u) { const size_t i = i0 + u * 64; if (i < (size_t)MTOK * 256) v[u] = (i < (size_t)NP * 256) ? ((const f32x4*)p.in[0])[i] : ((const f32x4*)p.in[1])[i - (size_t)NP * 256]; }
#pragma unroll
        for (int u = 0; u < 4; ++u) { const size_t i = i0 + u * 64; if (i < (size_t)MTOK * 256) { u32x2 w; w.x = pk2(v[u][0], v[u][1]); w.y = pk2(v[u][2], v[u][3]); ((u32x2*)Xb)[i] = w; } }
    }
}

__device__ __forceinline__ void ln_phase(const float* Z, const float* g, const float* b, float* Xf, bf16_t* Xb, int gw, int NGW, int lane) {
    f32x4 gv[4], bv[4];
#pragma unroll
    for (int j = 0; j < 4; ++j) { gv[j] = ((const f32x4*)g)[64 * j + lane]; bv[j] = ((const f32x4*)b)[64 * j + lane]; }
    f32x4 nx[4];
    if (gw < MTOK) {
#pragma unroll
        for (int j = 0; j < 4; ++j) nx[j] = ((const f32x4*)(Z + (size_t)gw * DM))[64 * j + lane];
    }
    for (int m = gw; m < MTOK; m += NGW) {
        f32x4 v[4]; float s = 0.f;
#pragma unroll
        for (int j = 0; j < 4; ++j) v[j] = nx[j];
        if (m + NGW < MTOK) {
#pragma unroll
            for (int j = 0; j < 4; ++j) nx[j] = ((const f32x4*)(Z + (size_t)(m + NGW) * DM))[64 * j + lane];
        }
#pragma unroll
        for (int j = 0; j < 4; ++j) s += (v[j][0] + v[j][1]) + (v[j][2] + v[j][3]);
        const float mean = wave_sum(s) * (1.f / DM); float s2 = 0.f;
#pragma unroll
        for (int j = 0; j < 4; ++j) { v[j] = v[j] - mean; s2 += (v[j][0] * v[j][0] + v[j][1] * v[j][1]) + (v[j][2] * v[j][2] + v[j][3] * v[j][3]); }
        const float rstd = 1.f / sqrtf(wave_sum(s2) * (1.f / DM) + 1e-5f);
        f32x4* xo = (f32x4*)(Xf + (size_t)m * DM) + lane; u32x2* xb = (u32x2*)(Xb + (size_t)m * DM) + lane;
#pragma unroll
        for (int j = 0; j < 4; ++j) { const f32x4 o = v[j] * rstd * gv[j] + bv[j]; xo[64 * j] = o;
            u32x2 w; w.x = pk2(o[0], o[1]); w.y = pk2(o[2], o[3]); xb[64 * j] = w; }
    }
}

__device__ __forceinline__ void even_prep(const Params& p, int j, LAS unsigned char* lds, const int wave_s) {
    const int lane = pg8_opaque_lane(), wave = wave_s, tid = wave_s * 64 + lane, fr = lane & 15, g4 = lane >> 4;
    size_t zoff = 0; asm volatile("" : "+s"(zoff));
    unsigned char* ws = p.ws + zoff;
    unsigned char* wss = ws + (size_t)j * SET_STRIDE;
    const bf16_t* P = (const bf16_t*)(ws + WS_P);
    float* SR = (float*)(wss + WS_SC); float* SW = (float*)(wss + WS_SC + SC_STRIDE); float* SK = (float*)(wss + WS_SC + 2 * SC_STRIDE);
    float* SV = (float*)(wss + WS_SC + 3 * SC_STRIDE); float* SKK = (float*)(wss + WS_SC + 4 * SC_STRIDE); float* SBB = (float*)(wss + WS_SC + 5 * SC_STRIDE);
    float* BON = (float*)(ws + WS_BON); bf16_t* MIX = (bf16_t*)(ws + WS_MIX);
    const float* mu = p.in[10] + j * ASW;
    const float* sshift = p.in[3] + (size_t)j * SB * ASW;
    const float* sconv = p.in[4] + (size_t)j * SB * 2 * 512;
    const int G = gridDim.x, per = (MTOK + G - 1) / G, n0 = blockIdx.x * per, n1 = min(MTOK, n0 + per);
#define ROWC(r) ((size_t)((r) < 0 ? 0 : ((r) > MTOK - 1 ? MTOK - 1 : (r))) * EINP)
    LAS bf16_t* Alds = (LAS bf16_t*)lds;
    LAS float* DW = (LAS float*)(lds + 16384 + wave * 8192);
    LAS float* DA = DW + 1024;
    bf16x8 wf[4][2], af[4][2];
#pragma unroll
    for (int nt = 0; nt < 4; ++nt)
#pragma unroll
        for (int ks = 0; ks < 2; ++ks)
#pragma unroll
            for (int e = 0; e < 8; ++e) { const size_t o = (size_t)(j * 64 + ks * 32 + g4 * 8 + e) * 512 + wave * 64 + nt * 16 + fr;
                wf[nt][ks][e] = (short)f2bf(p.in[12][o]); af[nt][ks][e] = (short)f2bf(p.in[14][o]); }
    const float mu_r = mu[tid], mu_k = mu[512 + tid], mu_v = mu[1024 + tid], mu_l = tid < 128 ? mu[1536 + tid] : 0.f;
    const float w0 = p.in[11][j * 512 + tid], a0 = p.in[13][j * 512 + tid], k_k = p.in[15][j * 512 + tid], k_a = p.in[16][j * 512 + tid], r_k = p.in[17][j * 512 + tid];
    const float cw0 = p.in[20][(j * 3 + 0) * 512 + tid], cw1 = p.in[20][(j * 3 + 1) * 512 + tid], cw2 = p.in[20][(j * 3 + 2) * 512 + tid];
    int par = 0;
    for (int nb = n0; nb < n1; nb += 16, par ^= 1) {
        LAS bf16_t* Ab = Alds + par * (16 * 136);
        if (tid < 128) {
            float cl[17];
#pragma unroll
            for (int i = 0; i < 17; ++i) cl[i] = bf2f(P[ROWC(nb - 1 + i) + 1536 + tid]);
#pragma unroll
            for (int i = 0; i < 16; ++i) { const int n = nb + i; const bool samp = n >= NP; const int t = samp ? ((n - NP) & 7) : (n & 2047), b = samp ? ((n - NP) >> 3) : 0;
                float ql = cl[i]; if (t == 0) ql = (samp && n < MTOK) ? sshift[b * ASW + 1536 + tid] : 0.f;
                float v = cl[i + 1] + (ql - cl[i + 1]) * mu_l; if (tid < 64) v = tanhf(v);
                Ab[i * 136 + tid] = (bf16_t)f2bf(v); }
        }
        __syncthreads();
        {
            const bf16x8 aw0 = *(const LAS bf16x8*)(Ab + fr * 136 + g4 * 8), aw1 = *(const LAS bf16x8*)(Ab + fr * 136 + 32 + g4 * 8);
            const bf16x8 aa0 = *(const LAS bf16x8*)(Ab + fr * 136 + 64 + g4 * 8), aa1 = *(const LAS bf16x8*)(Ab + fr * 136 + 96 + g4 * 8);
#pragma unroll
            for (int nt = 0; nt < 4; ++nt) {
                f32x4 dw = (f32x4){0.f, 0.f, 0.f, 0.f}, da = (f32x4){0.f, 0.f, 0.f, 0.f};
                dw = __builtin_amdgcn_mfma_f32_16x16x32_bf16(aw0, wf[nt][0], dw, 0, 0, 0); dw = __builtin_amdgcn_mfma_f32_16x16x32_bf16(aw1, wf[nt][1], dw, 0, 0, 0);
                da = __builtin_amdgcn_mfma_f32_16x16x32_bf16(aa0, af[nt][0], da, 0, 0, 0); da = __builtin_amdgcn_mfma_f32_16x16x32_bf16(aa1, af[nt][1], da, 0, 0, 0);
#pragma unroll
                for (int r = 0; r < 4; ++r) { DW[(g4 * 4 + r) * 64 + nt * 16 + fr] = dw[r]; DA[(g4 * 4 + r) * 64 + nt * 16 + fr] = da[r]; }
            }
        }
#pragma unroll 1
        for (int hh = 0; hh < 2; ++hh) {
            const int nh = nb + 8 * hh;
            if (nh >= n1) break;
            float ur[10], rr[9], kr[9], vr[9], bbv[8], zbv[8];
#pragma unroll
            for (int i = 0; i < 10; ++i) { const bf16_t* q = P + ROWC(nh - 2 + i); ur[i] = bf2f(q[2688 + tid]) * bf2f(q[3200 + tid]); }
#pragma unroll
            for (int i = 0; i < 9; ++i) { const bf16_t* q = P + ROWC(nh - 1 + i); rr[i] = bf2f(q[tid]); kr[i] = bf2f(q[512 + tid]); vr[i] = bf2f(q[1024 + tid]); }
#pragma unroll
            for (int i = 0; i < 8; ++i) { const bf16_t* q = P + ROWC(nh + i); bbv[i] = bf2f(q[2176 + tid]); zbv[i] = bf2f(q[3712 + tid]); }
#pragma unroll
            for (int i = 0; i < 8; ++i) { const int n = nh + i;
                if (n < n1) {
                    int b, t, T; const bool samp = n >= NP;
                    if (!samp) { b = n >> 11; t = n & 2047; T = SEQ; } else { const int s = n - NP; b = s >> 3; t = s & 7; T = ST; }
                    const float cr = rr[i + 1], ck = kr[i + 1], cv = vr[i + 1];
                    float qr = rr[i], qk = kr[i], qv = vr[i];
                    if (t == 0) { qr = 0.f; qk = 0.f; qv = 0.f; if (samp) { qr = sshift[b * ASW + tid]; qk = sshift[b * ASW + 512 + tid]; qv = sshift[b * ASW + 1024 + tid]; } }
                    const float sr = cr + (qr - cr) * mu_r, sk = ck + (qk - ck) * mu_k, sv = cv + (qv - cv) * mu_v;
                    const float wp = w0 + DW[(hh * 8 + i) * 64 + lane], ap = a0 + DA[(hh * 8 + i) * 64 + lane];
                    const float xs = -wp;
                    const float sp = xs > 20.f ? xs : __logf(1.f + __expf(xs));
                    const float decay = __expf(-__expf(-sp - 0.5f));
                    const float a = 1.f / (1.f + __expf(-ap));
                    const float kk = sk * k_k;
                    const float ss = wave_sum(kk * kk);
                    const float kkn = kk * rsqrtf(fmaxf(ss, 1e-24f));
                    const float kmod = sk * (1.f + (a - 1.f) * k_a);
                    const float bon = wave_sum(sr * kmod * r_k);
                    const size_t o = (size_t)n * 512 + tid;
                    SR[o] = sr; SW[o] = decay; SK[o] = kmod; SV[o] = sv; SKK[o] = kkn; SBB[o] = kkn * a;
                    if (lane == 0) BON[(size_t)n * 8 + wave] = bon;
                    if (t == T - 1) {
                        float* so = p.out + (samp ? O_SH_S + (size_t)(j * SB + b) * ASW : O_SH_P + (size_t)(j * PB + b) * ASW);
                        so[tid] = cr; so[512 + tid] = ck; so[1024 + tid] = cv; if (tid < 128) so[1536 + tid] = bf2f(P[(size_t)n * EINP + 1536 + tid]);
                    }
                    const float u0 = ur[i + 2];
                    float um1 = ur[i + 1], um2 = ur[i];
                    if (t < 1) um1 = samp ? sconv[(b * 2 + 1) * 512 + tid] : 0.f;
                    if (t < 2) um2 = samp ? sconv[(b * 2 + t) * 512 + tid] : 0.f;
                    const float yc = cw0 * um2 + cw1 * um1 + cw2 * u0;
                    MIX[(size_t)n * DM + 512 + tid] = (bf16_t)f2bf(bbv[i] * yc * silu(zbv[i]));
                    if (t >= T - 2) { float* co = p.out + (samp ? O_CV_S + (size_t)((j * SB + b) * 2 + (t - (T - 2))) * 512 : O_CV_P + (size_t)((j * PB + b) * 2 + (t - (T - 2))) * 512); co[tid] = u0; }
                } }
        }
    }
    __syncthreads();
#undef ROWC
}

constexpr int KVC_N0 = 32 * 128 * 256, KVC_N1 = 32 * 512 * 256, KVC_N2 = 32 * 2048 * 256, KVC_TOT = KVC_N0 + KVC_N1 + KVC_N2;
constexpr int CPS = 2;
__device__ __forceinline__ bool kvc_addr(const Params& p, int j, int i, const f32x4*& src, f32x4*& dst) {
    const size_t lbase = (size_t)j * SB * 2048 * 1024;
    src = (const f32x4*)(p.in[7] + lbase) + i; dst = (f32x4*)(p.out + O_KV2048_S + lbase) + (i - 2048);
    return i < KVC_N2 && ((i >> 8) & 2047) >= 8;
}
__device__ __forceinline__ void even_scan(const Params& p, int j, LAS unsigned char* lds, int gw, int NGW, int wave, int lane) {
    unsigned char* ws = p.ws;
    unsigned char* wss = ws + (size_t)j * SET_STRIDE;
    float* YL = (float*)(ws + WS_YL); float* QQ = (float*)(wss + WS_Q);
    float* LC = (float*)(ws + WS_LC); float* PC = (float*)(ws + WS_PC);
    LAS float* buf = (LAS float*)(lds + wave * 12288);
    const float* A0 = (const float*)(wss + WS_SC + 4 * SC_STRIDE);
    const float* A1 = (const float*)(wss + WS_SC + 1 * SC_STRIDE);
    const float* A2 = (const float*)(wss + WS_SC + 5 * SC_STRIDE);
    const float* A3 = (const float*)(wss + WS_SC + 2 * SC_STRIDE);
    const float* A4 = (const float*)(wss + WS_SC + 0 * SC_STRIDE);
    const float* A5 = (const float*)(wss + WS_SC + 3 * SC_STRIDE);
    const int ls = lane >> 4, lq = (lane & 15) * 4;
    const int cstride = CPS * NGW * 64; int cli = gw * 64 + lane;
    const size_t clb = (size_t)j * SB * 2048 * 1024;
    const f32x4* csrc = (const f32x4*)(p.in[7] + clb) + cli;
    const long long cdelta = (long long)((const char*)(p.out + O_KV2048_S + clb) - (const char*)(p.in[7] + clb)) - 2048 * 16;
    int cstep = 0;
    for (int task = gw; task < 64 * NCH + SB * 8 * 8; task += NGW) {
        const bool samp = task >= 64 * NCH;
        if (samp && ((task - 64 * NCH) & 7) != 0) continue;
        int n0, h, nst; size_t sidx;
        if (!samp) { const int bh = task / NCH, c = task % NCH; n0 = (bh >> 3) * SEQ + c * CH; h = bh & 7; nst = CH / TS; sidx = (size_t)task; }
        else { const int q = (task - 64 * NCH) >> 3, b = q >> 3; h = q & 7; n0 = NP + b * ST; nst = ST / TS; sidx = (size_t)(j * SB + b) * 8 + h; }
        float SL[4][16], SP[4][16];
        int i16 = lane & 15, cq = lane >> 4; asm volatile("" : "+v"(i16), "+v"(cq));
#pragma unroll
        for (int rr = 0; rr < 4; ++rr)
#pragma unroll
            for (int c = 0; c < 16; ++c) { SL[rr][c] = 0.f; SP[rr][c] = (i16 + 16 * rr == cq * 16 + c) ? 1.f : 0.f; }
        if (samp) {
#pragma unroll
            for (int rr = 0; rr < 4; ++rr) { const float* s0 = p.in[2] + sidx * 4096 + (i16 + 16 * rr) * 64 + cq * 16;
#pragma unroll
                for (int c = 0; c < 16; c += 4) { const f32x4 v = *(const f32x4*)(s0 + c); SL[rr][c] = v[0]; SL[rr][c + 1] = v[1]; SL[rr][c + 2] = v[2]; SL[rr][c + 3] = v[3]; } }
        }
        const size_t base = (size_t)n0 * 512 + h * 64;
        f32x4 rg[6];
        { const size_t o = base + (size_t)ls * 512 + lq;
          rg[0] = *(const f32x4*)(A0 + o); rg[1] = *(const f32x4*)(A1 + o); rg[2] = *(const f32x4*)(A2 + o); rg[3] = *(const f32x4*)(A3 + o); rg[4] = *(const f32x4*)(A4 + o); rg[5] = *(const f32x4*)(A5 + o);
#pragma unroll
          for (int a = 0; a < 6; ++a) *(LAS f32x4*)(buf + ls * 384 + a * 64 + lq) = rg[a]; }
        for (int st = 0; st < nst; ++st) {
            const bool more = st + 1 < nst;
            if (more) { const size_t o = base + (size_t)((st + 1) * TS + ls) * 512 + lq;
                rg[0] = *(const f32x4*)(A0 + o); rg[1] = *(const f32x4*)(A1 + o); rg[2] = *(const f32x4*)(A2 + o); rg[3] = *(const f32x4*)(A3 + o); rg[4] = *(const f32x4*)(A4 + o); rg[5] = *(const f32x4*)(A5 + o); }
            LAS float* bb = buf + (st & 1) * (TS * 384);
#pragma unroll 1
            for (int s = 0; s < TS; ++s) {
                const LAS float* sb = bb + s * 384 + cq * 16;
                f32x4 cbuf[CPS];
#pragma unroll
                for (int c = 0; c < CPS; ++c) { const int li = cli + c * NGW * 64;
                    if (li < KVC_N2 && ((li >> 8) & 2047) >= 8) cbuf[c] = __builtin_nontemporal_load(csrc + c * NGW * 64); }
                float saL[4], saP[4];
#pragma unroll
                for (int rr = 0; rr < 4; ++rr) { saL[rr] = 0.f; saP[rr] = 0.f; }
#pragma unroll
                for (int c = 0; c < 16; c += 4) { const f32x4 k4 = *(const LAS f32x4*)(sb + c);
#pragma unroll
                    for (int rr = 0; rr < 4; ++rr)
#pragma unroll
                        for (int e = 0; e < 4; ++e) { saL[rr] = fnma_s(SL[rr][c + e], k4[e], saL[rr]); saP[rr] = fnma_s(SP[rr][c + e], k4[e], saP[rr]); } }
                float vv[4];
#pragma unroll
                for (int rr = 0; rr < 4; ++rr) { vv[rr] = bb[s * 384 + 320 + i16 + 16 * rr];
                }
                {
                    float a = saL[0], b = saL[1], c = saL[2], d = saL[3]; swap16_(a, b); swap16_(c, d); float s01 = a + b, s23 = c + d; swap32_(s01, s23); const float T = s01 + s23;
                    float u = T, w = T; swap16_(u, w); float x0 = u, x2 = u, x1 = w, x3 = w; swap32_(x0, x2); swap32_(x1, x3); saL[0] = x0; saL[1] = x1; saL[2] = x2; saL[3] = x3;
                }
                {
                    float a = saP[0], b = saP[1], c = saP[2], d = saP[3]; swap16_(a, b); swap16_(c, d); float s01 = a + b, s23 = c + d; swap32_(s01, s23); const float T = s01 + s23;
                    float u = T, w = T; swap16_(u, w); float x0 = u, x2 = u, x1 = w, x3 = w; swap32_(x0, x2); swap32_(x1, x3); saP[0] = x0; saP[1] = x1; saP[2] = x2; saP[3] = x3;
                }
                float yL[4], yP[4];
#pragma unroll
                for (int rr = 0; rr < 4; ++rr) { yL[rr] = 0.f; yP[rr] = 0.f; }
#pragma unroll
                for (int c = 0; c < 16; c += 4) {
                    const f32x4 w4 = *(const LAS f32x4*)(sb + 64 + c), b4 = *(const LAS f32x4*)(sb + 128 + c), k4 = *(const LAS f32x4*)(sb + 192 + c), r4 = *(const LAS f32x4*)(sb + 256 + c);
#pragma unroll
                    for (int rr = 0; rr < 4; ++rr)
#pragma unroll
                        for (int e = 0; e < 4; ++e) {
                            float tL = mul_s(saL[rr], b4[e]); tL = fma_s(vv[rr], k4[e], tL); SL[rr][c + e] = fma_s(SL[rr][c + e], w4[e], tL); yL[rr] = fma_s(SL[rr][c + e], r4[e], yL[rr]);
                            const float tP = mul_s(saP[rr], b4[e]); SP[rr][c + e] = fma_s(SP[rr][c + e], w4[e], tP); yP[rr] = fma_s(SP[rr][c + e], r4[e], yP[rr]); }
                }
                float yoL, yoP;
                { float a = yL[0], b = yL[1], c = yL[2], d = yL[3]; swap16_(a, b); swap16_(c, d); float s01 = a + b, s23 = c + d; swap32_(s01, s23); yoL = s01 + s23; }
                { float a = yP[0], b = yP[1], c = yP[2], d = yP[3]; swap16_(a, b); swap16_(c, d); float s01 = a + b, s23 = c + d; swap32_(s01, s23); yoP = s01 + s23; }
                const size_t oo = base + (size_t)(st * TS + s) * 512 + lane;
                YL[oo] = yoL; if (!samp) QQ[oo] = yoP;
#pragma unroll
                for (int c = 0; c < CPS; ++c) { const int li = cli + c * NGW * 64;
                    if (li < KVC_N2 && ((li >> 8) & 2047) >= 8) __builtin_nontemporal_store(cbuf[c], (f32x4*)((char*)(csrc + c * NGW * 64) + cdelta)); }
                cli += cstride; csrc += cstride; ++cstep;
            }
            if (more) {
#pragma unroll
                for (int a = 0; a < 6; ++a) *(LAS f32x4*)(buf + ((st + 1) & 1) * (TS * 384) + ls * 384 + a * 64 + lq) = rg[a]; }
        }
        {
            float* dl = samp ? p.out + O_RWKV_S + sidx * 4096 : LC + sidx * 4096; float* dp = PC + sidx * 4096;
#pragma unroll
            for (int rr = 0; rr < 4; ++rr) { const int ro = (i16 + 16 * rr) * 64 + cq * 16;
#pragma unroll
                for (int c = 0; c < 16; c += 4) { *(f32x4*)(dl + ro + c) = (f32x4){SL[rr][c], SL[rr][c + 1], SL[rr][c + 2], SL[rr][c + 3]};
                    if (!samp) *(f32x4*)(dp + ro + c) = (f32x4){SP[rr][c], SP[rr][c + 1], SP[rr][c + 2], SP[rr][c + 3]}; } }
        }
    }
    for (; cli < KVC_N2; cli += NGW * 64, csrc += NGW * 64) { if (((cli >> 8) & 2047) >= 8) __builtin_nontemporal_store(__builtin_nontemporal_load(csrc), (f32x4*)((char*)csrc + cdelta)); }
}

typedef float f32x4c __attribute__((ext_vector_type(4)));
__device__ __forceinline__ void even_carry(const Params& p, int j, LAS unsigned char* lds, const int wave_s) {
    unsigned char* ws = p.ws;
    const float* LC = (const float*)(ws + WS_LC); const float* PC = (const float*)(ws + WS_PC); float* SST = (float*)(ws + WS_SST);
    LAS float* Ss = (LAS float*)lds;
    const int lane = pg8_opaque_lane(), fr = lane & 15, g4 = lane >> 4, ct = wave_s;
    for (int unit = blockIdx.x; unit < 256; unit += gridDim.x) {
        const int bh = unit >> 2, r0 = (unit & 3) * 16;
        const size_t cb0 = (size_t)(bh * NCH) * 4096;
        if (ct < 4) {
            float pr[4][16]; f32x4c lr[4];
#define CARRY_LOAD(Q, C) do { const float* pc_ = PC + cb0 + (size_t)(C) * 4096 + g4 * 64 + ct * 16 + fr; \
                _Pragma("unroll") for (int kk = 0; kk < 16; ++kk) pr[Q][kk] = pc_[kk * 256]; \
                const float* lc_ = LC + cb0 + (size_t)(C) * 4096 + (size_t)(r0 + g4 * 4) * 64 + ct * 16 + fr; \
                lr[Q] = (f32x4c){lc_[0], lc_[64], lc_[128], lc_[192]}; } while (0)
            CARRY_LOAD(0, 0); CARRY_LOAD(1, 1); CARRY_LOAD(2, 2); CARRY_LOAD(3, 3);
            f32x4c d = (f32x4c){0.f, 0.f, 0.f, 0.f};
            for (int c4 = 0; c4 < NCH; c4 += 4) {
#pragma unroll
                for (int q = 0; q < 4; ++q) {
                    const int c = c4 + q;
                    float* sst = SST + cb0 + (size_t)c * 4096 + (size_t)(r0 + g4 * 4) * 64 + ct * 16 + fr;
                    LAS float* sb = Ss + (c & 1) * 1024;
#pragma unroll
                    for (int r = 0; r < 4; ++r) { sst[r * 64] = d[r]; sb[(g4 * 4 + r) * 64 + ct * 16 + fr] = d[r]; }
                    __syncthreads();
                    f32x4c acc = lr[q];
#pragma unroll
                    for (int kk = 0; kk < 16; ++kk) acc = __builtin_amdgcn_mfma_f32_16x16x4f32(sb[fr * 64 + kk * 4 + g4], pr[q][kk], acc, 0, 0, 0);
                    d = acc;
                    if (c + 4 < NCH) CARRY_LOAD(q, c + 4);
                }
            }
#pragma unroll
            for (int r = 0; r < 4; ++r) p.out[O_RWKV_P + (size_t)(j * 64 + bh) * 4096 + (size_t)(r0 + g4 * 4 + r) * 64 + ct * 16 + fr] = d[r];
#undef CARRY_LOAD
        } else {
            for (int c = 0; c < NCH; ++c) __syncthreads();
        }
        __syncthreads();
    }
}

__device__ __forceinline__ void even_finish_vals(float y, float gg, float gb, float bon, float v, float zA, bf16_t* dst) {
    const float mean = wave_sum(y) * (1.f / 64.f);
    const float d = y - mean;
    const float var = wave_sum(d * d) * (1.f / 64.f);
    const float yn = d * rsqrtf(var + 64e-5f) * gg + gb + bon * v;
    *dst = (bf16_t)f2bf(yn * silu(zA));
}

__device__ __forceinline__ void even_fixup(const Params& p, int j, LAS unsigned char* lds, int gw, int NGW, int wave, int lane) {
    unsigned char* ws = p.ws;
    unsigned char* wss = ws + (size_t)j * SET_STRIDE;
    const float* YL = (const float*)(ws + WS_YL); const float* QQ = (const float*)(wss + WS_Q); const float* SST = (const float*)(ws + WS_SST);
    const float* BON = (const float*)(ws + WS_BON); const float* SV = (const float*)(wss + WS_SC + 3 * SC_STRIDE);
    const bf16_t* P = (const bf16_t*)(ws + WS_P); bf16_t* MIX = (bf16_t*)(ws + WS_MIX);
    LAS float* qb = (LAS float*)(lds + wave * 16384);
    const int fr = lane & 15, g4 = lane >> 4;
    for (int task = gw; task < 64 * NCH; task += NGW) {
        const int bh = task / NCH, c = task % NCH, b = bh >> 3, h = bh & 7, nb = b * SEQ + c * CH;
        { const float* qg = QQ + (size_t)nb * 512 + h * 64 + (lane & 15) * 4;
          f32x4 t[16];
#pragma unroll
          for (int i = 0; i < 16; ++i) t[i] = *(const f32x4*)(qg + (size_t)(i * 4 + (lane >> 4)) * 512);
#pragma unroll
          for (int i = 0; i < 16; ++i) *(LAS f32x4*)(qb + (i * 4 + (lane >> 4)) * 64 + (lane & 15) * 4) = t[i]; }
        float Sb[4][16], gg[4], gb[4];
        const float* s0 = SST + (size_t)task * 4096 + fr * 64 + g4;
#pragma unroll
        for (int it = 0; it < 4; ++it) { gg[it] = p.in[18][j * 512 + h * 64 + it * 16 + fr]; gb[it] = p.in[19][j * 512 + h * 64 + it * 16 + fr];
#pragma unroll
            for (int kk = 0; kk < 16; ++kk) Sb[it][kk] = s0[it * 1024 + kk * 4]; }
#pragma unroll 1
        for (int tt = 0; tt < 4; ++tt) {
            float yl[4][4], vv[4][4], za[4][4], bon[4];
#pragma unroll
            for (int r = 0; r < 4; ++r) { const size_t n = (size_t)(nb + tt * 16 + g4 * 4 + r); bon[r] = BON[n * 8 + h];
#pragma unroll
                for (int it = 0; it < 4; ++it) { const int ch = h * 64 + it * 16 + fr; yl[r][it] = YL[n * 512 + ch]; vv[r][it] = SV[n * 512 + ch]; za[r][it] = bf2f(P[n * EINP + ASW + ch]); } }
            f32x4 acc[4];
#pragma unroll
            for (int it = 0; it < 4; ++it) acc[it] = (f32x4){0.f, 0.f, 0.f, 0.f};
#pragma unroll
            for (int kk = 0; kk < 16; ++kk) { const float av = qb[(tt * 16 + fr) * 64 + kk * 4 + g4];
#pragma unroll
                for (int it = 0; it < 4; ++it) acc[it] = __builtin_amdgcn_mfma_f32_16x16x4f32(av, Sb[it][kk], acc[it], 0, 0, 0); }
#pragma unroll
            for (int r = 0; r < 4; ++r) {
                float y[4];
#pragma unroll
                for (int it = 0; it < 4; ++it) y[it] = acc[it][r] + yl[r][it];
                const float mean = row16_sum((y[0] + y[1]) + (y[2] + y[3])) * (1.f / 64.f);
#pragma unroll
                for (int it = 0; it < 4; ++it) y[it] -= mean;
                const float var = row16_sum((y[0] * y[0] + y[1] * y[1]) + (y[2] * y[2] + y[3] * y[3])) * (1.f / 64.f);
                const float rs = rsqrtf(var + 64e-5f);
                const size_t n = (size_t)(nb + tt * 16 + g4 * 4 + r);
#pragma unroll
                for (int it = 0; it < 4; ++it) { const float yn = y[it] * rs * gg[it] + gb[it] + bon[r] * vv[r][it];
                    MIX[n * DM + h * 64 + it * 16 + fr] = (bf16_t)f2bf(yn * silu(za[r][it])); }
            }
        }
    }
    for (int task = gw; task < NS * 8; task += NGW) {
        const int n = NP + (task >> 3), h = task & 7, ch = h * 64 + lane;
        even_finish_vals(YL[(size_t)n * 512 + ch], p.in[18][j * 512 + ch], p.in[19][j * 512 + ch], BON[(size_t)n * 8 + h], SV[(size_t)n * 512 + ch], bf2f(P[(size_t)n * EINP + ASW + ch]), MIX + (size_t)n * DM + ch);
    }
}

__device__ __forceinline__ void attn_prompt(const Params& p, int j, LAS unsigned char* lds, const int wave, const int lane) {
    unsigned char* ws = p.ws;
    const bf16_t* P = (const bf16_t*)(ws + WS_P);
    bf16_t* OG = (bf16_t*)(ws + WS_OG); float* LSE = (float*)(ws + WS_LSE);
    LAS unsigned char* Kl = lds;
    LAS unsigned char* Vl = lds + 39424;
    const int fr = lane & 15, g4 = lane >> 4, tid = wave * 64 + lane;
    typedef short s16x4_ __attribute__((ext_vector_type(4)));
    u32x4 kreg[5], vreg[5]; bf16x8 qn0, qn1;
#define ATT_DECODE(BT, G_, DSH_, RHO_, B_, H_, Q0B_) const int G_ = (BT) >> 10, r_ = (BT) & 1023, DSH_ = G_ * 2, tb_ = (SEQ >> DSH_) >> 7, qb_ = r_ % tb_, r2_ = r_ / tb_, \
        RHO_ = r2_ & ((1 << DSH_) - 1), bh_ = r2_ >> DSH_, B_ = bh_ >> 3, H_ = bh_ & 7, Q0B_ = qb_ * 128
#define ATT_LOAD(BT) do { ATT_DECODE(BT, g_, dsh_, rho_, b_, h_, q0b_); const bf16_t* Pb_ = P + (size_t)b_ * SEQ * OIN + g_ * 512 + h_ * 64; \
        _Pragma("unroll") for (int i = 0; i < 5; ++i) { const int idx = tid + 512 * i; if (idx < 2176) { int uk = q0b_ - 144 + (idx >> 3); uk = uk < 0 ? 0 : uk; \
            const bf16_t* rp = Pb_ + (size_t)((uk << dsh_) + rho_) * OIN + (idx & 7) * 8; kreg[i] = *(const u32x4*)(rp + 1536); vreg[i] = *(const u32x4*)(rp + 3072); } } \
        { const bf16_t* qp_ = Pb_ + (size_t)(((q0b_ + 16 * wave + fr) << dsh_) + rho_) * OIN + g4 * 8; qn0 = *(const bf16x8*)qp_; qn1 = *(const bf16x8*)(qp_ + 32); } } while (0)
    int bt = blockIdx.x;
    if (bt < 3072) ATT_LOAD(bt);
    for (; bt < 3072; bt += gridDim.x) {
#pragma unroll
        for (int i = 0; i < 5; ++i) { const int idx = tid + 512 * i; if (idx < 2176) { const int row = idx >> 3, ch = idx & 7;
            *(LAS u32x4*)(Kl + row * 144 + ch * 16) = kreg[i];
            *(LAS u32x2*)(Vl + row * 136 + ch * 16) = (u32x2){vreg[i].x, vreg[i].y}; *(LAS u32x2*)(Vl + row * 136 + ch * 16 + 8) = (u32x2){vreg[i].z, vreg[i].w}; } }
        __syncthreads();
        const bf16x8 qf0 = qn0, qf1 = qn1;
        if (bt + (int)gridDim.x < 3072) ATT_LOAD(bt + (int)gridDim.x);
        ATT_DECODE(bt, g, dsh, rho, b, h, q0b);
        const int q0 = q0b + 16 * wave;
        const bf16_t* Pb = P + (size_t)b * SEQ * OIN + g * 512 + h * 64;
        const int tq = ((q0 + fr) << dsh) + rho;
        f32x4 acc[4];
#pragma unroll
        for (int dt = 0; dt < 4; ++dt) acc[dt] = (f32x4){0.f, 0.f, 0.f, 0.f};
        float mrun = -1e30f, lrun = 0.f;
        const int uq = q0 + fr;
        const int kp0 = q0 >= 113 ? 0 : (113 - q0 + 31) / 32;
        for (int kp = kp0; kp < 5; ++kp) {
            const int kbase = q0 - 144 + 32 * kp, lrow = 16 * wave + 32 * kp;
            f32x4 st[2];
#pragma unroll
            for (int tl = 0; tl < 2; ++tl) {
                const LAS unsigned char* kr = Kl + (lrow + tl * 16 + fr) * 144 + g4 * 16;
                const bf16x8 kf0 = *(const LAS bf16x8*)kr, kf1 = *(const LAS bf16x8*)(kr + 64);
                f32x4 sv = (f32x4){0.f, 0.f, 0.f, 0.f};
                sv = __builtin_amdgcn_mfma_f32_16x16x32_bf16(kf0, qf0, sv, 0, 0, 0);
                sv = __builtin_amdgcn_mfma_f32_16x16x32_bf16(kf1, qf1, sv, 0, 0, 0);
                st[tl] = sv;
            }
            float mx = -1e30f; bool val[2][4];
#pragma unroll
            for (int tl = 0; tl < 2; ++tl)
#pragma unroll
                for (int e = 0; e < 4; ++e) { const int uk = kbase + tl * 16 + g4 * 4 + e, dist = uq - uk; val[tl][e] = (uk >= 0) && (dist >= 0) && (dist <= 128);
                    st[tl][e] = val[tl][e] ? st[tl][e] * 0.125f : -1e30f; mx = fmaxf(mx, st[tl][e]); }
            mx = xmax4(mx);
            const float mnew = fmaxf(mrun, mx), sc = __expf(mrun - mnew);
            mrun = mnew; lrun *= sc;
#pragma unroll
            for (int dt = 0; dt < 4; ++dt) acc[dt] = acc[dt] * sc;
            float pv[2][4];
#pragma unroll
            for (int tl = 0; tl < 2; ++tl)
#pragma unroll
                for (int e = 0; e < 4; ++e) { pv[tl][e] = val[tl][e] ? __expf(st[tl][e] - mnew) : 0.f; lrun += pv[tl][e]; }
            bf16x8 pf;
            { u32x4 w; w.x = pk2(pv[0][0], pv[0][1]); w.y = pk2(pv[0][2], pv[0][3]); w.z = pk2(pv[1][0], pv[1][1]); w.w = pk2(pv[1][2], pv[1][3]); pf = __builtin_bit_cast(bf16x8, w); }
#pragma unroll
            for (int dt = 0; dt < 4; ++dt) {
                LAS unsigned char* ta = Vl + (lrow + g4 * 4 + (fr >> 2)) * 136 + dt * 32 + 8 * (fr & 3);
                const s16x4_ lo = __builtin_amdgcn_ds_read_tr16_b64_v4i16((LAS s16x4_*)ta), hi = __builtin_amdgcn_ds_read_tr16_b64_v4i16((LAS s16x4_*)(ta + 2176));
                const bf16x8 vf = (bf16x8){lo[0], lo[1], lo[2], lo[3], hi[0], hi[1], hi[2], hi[3]};
                acc[dt] = __builtin_amdgcn_mfma_f32_16x16x32_bf16(vf, pf, acc[dt], 0, 0, 0);
            }
        }
        lrun = xsum4(lrun);
        const float inv = 1.f / lrun;
        const size_t n = (size_t)b * SEQ + tq;
        bf16_t* og = OG + ((size_t)g * NP + n) * 512 + h * 64 + g4 * 4;
#pragma unroll
        for (int dt = 0; dt < 4; ++dt) { u32x2 w; w.x = pk2(acc[dt][0] * inv, acc[dt][1] * inv); w.y = pk2(acc[dt][2] * inv, acc[dt][3] * inv); *(u32x2*)(og + dt * 16) = w; }
        if (g4 == 0) LSE[((size_t)g * NP + n) * 8 + h] = mrun + __logf(lrun);
        __syncthreads();
    }
#undef ATT_LOAD
#undef ATT_DECODE
}

__device__ __forceinline__ void attn_sample(const Params& p, int j, LAS unsigned char* lds, int gw, int NGW, int wave, int lane) {
    unsigned char* ws = p.ws;
    const bf16_t* P = (const bf16_t*)(ws + WS_P);
    LAS float* scs = (LAS float*)(lds + 40960 + wave * 2560);
    const int rs = lane >> 4, ch = lane & 15;
    for (int task = gw; task < NS * 8; task += NGW) {
        const int t = task & 7, h = (task >> 3) & 7, b = task >> 6, s = b * 8 + t, n = NP + s;
        f32x4 qv[3];
#pragma unroll
        for (int g = 0; g < 3; ++g) { const u32x2 w = *(const u32x2*)(P + (size_t)n * OIN + g * 512 + h * 64 + ch * 4);
            qv[g] = (f32x4){__uint_as_float(w.x << 16), __uint_as_float(w.x & 0xffff0000u), __uint_as_float(w.y << 16), __uint_as_float(w.y & 0xffff0000u)} * 0.125f; }
        float mx = -1e30f;
#pragma unroll
        for (int g = 0; g < 3; ++g) {
            const int W = g == 0 ? 128 : (g == 1 ? 512 : 2048), dsh = 2 * g;
            const float* cache = (g == 0 ? p.in[5] : (g == 1 ? p.in[6] : p.in[7])) + (size_t)(j * SB + b) * W * 1024 + h * 64 + ch * 4;
            const float* nbuf = p.out + (g == 0 ? O_KV128_S : (g == 1 ? O_KV512_S : O_KV2048_S)) + (size_t)(j * SB + b) * W * 1024 + h * 64 + ch * 4;
#pragma unroll 1
            for (int jj0 = 0; jj0 < 129; jj0 += 64) {
                f32x4 kv[16];
#pragma unroll
                for (int u = 0; u < 16; ++u) { int jj = jj0 + u * 4 + rs; jj = jj > 128 ? 128 : jj; const int pos = W + t - (jj << dsh);
                    kv[u] = *(const f32x4*)(pos >= W ? nbuf + (size_t)(pos - 8) * 1024 : cache + (size_t)pos * 1024); }
#pragma unroll
                for (int u = 0; u < 16; ++u) { const int jj = jj0 + u * 4 + rs;
                    const float d = row16_sum(kv[u][0] * qv[g][0] + kv[u][1] * qv[g][1] + kv[u][2] * qv[g][2] + kv[u][3] * qv[g][3]);
                    if (jj <= 128) { mx = fmaxf(mx, d); if (ch == 0) scs[g * 129 + jj] = d; } }
            }
        }
        mx = wave_max(mx);
        float lsum = 0.f;
        for (int i = lane; i < 387; i += 64) { const float e = __expf(scs[i] - mx); scs[i] = e; lsum += e; }
        lsum = wave_sum(lsum);
        f32x4 acc = (f32x4){0.f, 0.f, 0.f, 0.f};
#pragma unroll
        for (int g = 0; g < 3; ++g) {
            const int W = g == 0 ? 128 : (g == 1 ? 512 : 2048), dsh = 2 * g;
            const float* cache = (g == 0 ? p.in[5] : (g == 1 ? p.in[6] : p.in[7])) + (size_t)(j * SB + b) * W * 1024 + 512 + h * 64 + ch * 4;
            const float* nbuf = p.out + (g == 0 ? O_KV128_S : (g == 1 ? O_KV512_S : O_KV2048_S)) + (size_t)(j * SB + b) * W * 1024 + 512 + h * 64 + ch * 4;
#pragma unroll 1
            for (int jj0 = 0; jj0 < 129; jj0 += 64) {
                f32x4 vv[16]; float pj[16];
#pragma unroll
                for (int u = 0; u < 16; ++u) { int jj = jj0 + u * 4 + rs; const bool ok = jj <= 128; jj = ok ? jj : 128; const int pos = W + t - (jj << dsh);
                    vv[u] = *(const f32x4*)(pos >= W ? nbuf + (size_t)(pos - 8) * 1024 : cache + (size_t)pos * 1024);
                    pj[u] = ok ? scs[g * 129 + jj] : 0.f; }
#pragma unroll
                for (int u = 0; u < 16; ++u) acc += vv[u] * pj[u];
            }
        }
        acc[0] = xsum4(acc[0]); acc[1] = xsum4(acc[1]); acc[2] = xsum4(acc[2]); acc[3] = xsum4(acc[3]);
        if (rs == 0) {
            const float inv = 1.f / lsum;
            const u32x2 zw = *(const u32x2*)(P + (size_t)n * OIN + 4608 + h * 64 + ch * 4);
            const float z0 = __uint_as_float(zw.x << 16), z1 = __uint_as_float(zw.x & 0xffff0000u), z2 = __uint_as_float(zw.y << 16), z3 = __uint_as_float(zw.y & 0xffff0000u);
            u32x2 o; o.x = pk2(acc[0] * inv * silu(z0), acc[1] * inv * silu(z1)); o.y = pk2(acc[2] * inv * silu(z2), acc[3] * inv * silu(z3));
            *(u32x2*)((bf16_t*)(ws + WS_MIX) + (size_t)n * 512 + h * 64 + ch * 4) = o;
        }
    }
}

__device__ __forceinline__ void kv_copy(const Params& p, int j, int gw, int NGW, int lane) {
#pragma unroll
    for (int g = 0; g < 2; ++g) {
        const int W = g == 0 ? 128 : (g == 1 ? 512 : 2048);
        const float* cache = (g == 0 ? p.in[5] : (g == 1 ? p.in[6] : p.in[7])) + (size_t)j * SB * W * 1024;
        float* ob = p.out + (g == 0 ? O_KV128_S : (g == 1 ? O_KV512_S : O_KV2048_S)) + (size_t)j * SB * W * 1024;
        const long per = (long)(W - 8) * 256, tot = per * SB;
        for (long i0 = (long)gw * 512 + lane; i0 < tot; i0 += (long)NGW * 512) {
            f32x4 v[8];
#pragma unroll
            for (int u = 0; u < 8; ++u) { const long i = i0 + u * 64; if (i < tot) { const long b = i / per, o = i - b * per; v[u] = __builtin_nontemporal_load((const f32x4*)(cache + (b * W + 8) * 1024) + o); } }
#pragma unroll
            for (int u = 0; u < 8; ++u) { const long i = i0 + u * 64; if (i < tot) { const long b = i / per, o = i - b * per; __builtin_nontemporal_store(v[u], (f32x4*)(ob + b * W * 1024) + o); } }
        }
    }
}

__device__ __forceinline__ void attn_merge(const Params& p, int gw, int NGW, int lane) {
    unsigned char* ws = p.ws;
    const bf16_t* P = (const bf16_t*)(ws + WS_P); const bf16_t* OG = (const bf16_t*)(ws + WS_OG); const float* LSE = (const float*)(ws + WS_LSE);
    bf16_t* MIX = (bf16_t*)(ws + WS_MIX);
    const int h = lane >> 3;
    float nl0 = 0.f, nl1 = 0.f, nl2 = 0.f; u32x4 na = {0u, 0u, 0u, 0u}, nb = na, nc = na, nz = na;
#define MERGE_LOAD(N) do { const size_t n_ = (size_t)(N); nl0 = LSE[((size_t)0 * NP + n_) * 8 + h]; nl1 = LSE[((size_t)1 * NP + n_) * 8 + h]; nl2 = LSE[((size_t)2 * NP + n_) * 8 + h]; \
        na = *(const u32x4*)(OG + ((size_t)0 * NP + n_) * 512 + lane * 8); nb = *(const u32x4*)(OG + ((size_t)1 * NP + n_) * 512 + lane * 8); \
        nc = *(const u32x4*)(OG + ((size_t)2 * NP + n_) * 512 + lane * 8); nz = *(const u32x4*)(P + n_ * OIN + 4608 + lane * 8); } while (0)
    if (gw < NP) MERGE_LOAD(gw);
    for (int n = gw; n < NP; n += NGW) {
        const float l0 = nl0, l1 = nl1, l2 = nl2; const u32x4 a = na, bq = nb, c = nc, z = nz;
        if (n + NGW < NP) MERGE_LOAD(n + NGW);
        const float m = fmaxf(l0, fmaxf(l1, l2));
        float e0 = __expf(l0 - m), e1 = __expf(l1 - m), e2 = __expf(l2 - m);
        const float inv = 1.f / (e0 + e1 + e2); e0 *= inv; e1 *= inv; e2 *= inv;
        u32x4 o;
#pragma unroll
        for (int i = 0; i < 4; ++i) {
            const float alo = __uint_as_float(a[i] << 16), ahi = __uint_as_float(a[i] & 0xffff0000u), blo = __uint_as_float(bq[i] << 16), bhi = __uint_as_float(bq[i] & 0xffff0000u);
            const float clo = __uint_as_float(c[i] << 16), chi = __uint_as_float(c[i] & 0xffff0000u), zlo = __uint_as_float(z[i] << 16), zhi = __uint_as_float(z[i] & 0xffff0000u);
            const float olo = (e0 * alo + e1 * blo + e2 * clo) * silu(zlo), ohi = (e0 * ahi + e1 * bhi + e2 * chi) * silu(zhi);
            o[i] = pk2(olo, ohi);
        }
        *(u32x4*)(MIX + (size_t)n * 512 + lane * 8) = o;
    }
#undef MERGE_LOAD
}


#define RLX_AGENT __ATOMIC_RELAXED, __HIP_MEMORY_SCOPE_AGENT
#define XB_TMO      128
#define XB_XCNT(j)  (256  + 64 * (j))
#define XB_XSUB(j)  (1280 + 64 * (j))
#define XB_XGEN(j)  (2304 + 64 * (j))
#define XB_TOP      3328
#define XB_TOPGEN   3392
#define XCD_BAR_WORDS 3456
#define XB_SPIN_CAP (1u << 18)

__device__ __forceinline__ unsigned xb_ld(unsigned* p)              { return __hip_atomic_load(p, __ATOMIC_RELAXED, __HIP_MEMORY_SCOPE_AGENT); }
__device__ __forceinline__ unsigned xb_add(unsigned* p, unsigned v) { return __hip_atomic_fetch_add(p, v, __ATOMIC_RELAXED, __HIP_MEMORY_SCOPE_AGENT); }
__device__ __forceinline__ unsigned xb_xcc_id() { return (unsigned)__builtin_amdgcn_s_getreg((3 << 11) | 20) & 0xFu; }
#define XB_SPIN(cond, bar) do { unsigned _sp = 0; while (cond) { __builtin_amdgcn_s_sleep(1); \
    if ((++_sp & 255u) == 0u) { if (xb_ld(&(bar)[XB_TMO])) break; if (_sp > XB_SPIN_CAP) { atomicAdd(&(bar)[XB_TMO], 1u); break; } } } } while (0)

struct XcdBarrier {
    unsigned* bar; unsigned x; int wv;
    volatile LAS unsigned* st;
};

__device__ __forceinline__ XcdBarrier xcd_barrier_post(unsigned* bar, volatile LAS unsigned* st, int wv) {
    XcdBarrier b; b.bar = bar; b.x = xb_xcc_id(); b.st = st; b.wv = wv;
    if (wv == 0 && pg8_opaque_lane() == 0) (void)xb_add(&bar[XB_XCNT(b.x)], 1u);
    return b;
}
__device__ __forceinline__ void xcd_barrier_complete(unsigned* bar, unsigned x, unsigned& nloc, unsigned& nx) {
    const unsigned G = gridDim.x * gridDim.y * gridDim.z;
    unsigned sum, cnt, mine, sp = 0u;
    for (;;) {
        sum = 0u; cnt = 0u; mine = 0u;
#pragma unroll
        for (unsigned j = 0; j < 16; ++j) { const unsigned c = xb_ld(&bar[XB_XCNT(j)]); sum += c; cnt += (c > 0u) ? 1u : 0u; mine = (j == x) ? c : mine; }
        if (sum == G) break;
        __builtin_amdgcn_s_sleep(1);
        if ((++sp & 255u) == 0u) { if (xb_ld(&bar[XB_TMO])) break; if (sp > XB_SPIN_CAP) { atomicAdd(&bar[XB_TMO], 1u); break; } }
    }
    nloc = mine > 0u ? mine : 1u; nx = cnt > 0u ? cnt : 1u;
}

__device__ __forceinline__ void xcd_barrier(const XcdBarrier& b) {
    asm volatile("s_waitcnt vmcnt(0)" ::: "memory");
    __syncthreads();
    if (b.wv == 0 && pg8_opaque_lane() == 0) {
        unsigned* bar = b.bar;
        __builtin_amdgcn_s_waitcnt(0);
        unsigned nloc = b.st[0], nx = b.st[1];
        if (nloc == 0u) { xcd_barrier_complete(bar, b.x, nloc, nx); b.st[0] = nloc; b.st[1] = nx; }
        const unsigned old = xb_add(&bar[XB_XSUB(b.x)], 1u);
        const unsigned gen = old / nloc;
        if (old + 1u == (gen + 1u) * nloc) {
            __builtin_amdgcn_fence(__ATOMIC_RELEASE, "agent");
            asm volatile("s_waitcnt vmcnt(0)" ::: "memory");
            const unsigned og = xb_add(&bar[XB_TOP], 1u);
            const unsigned tg = og / nx;
            if (og + 1u == (tg + 1u) * nx) xb_add(&bar[XB_TOPGEN], 1u);
            else XB_SPIN(xb_ld(&bar[XB_TOPGEN]) == tg, bar);
            __builtin_amdgcn_fence(__ATOMIC_ACQUIRE, "agent");
            xb_add(&bar[XB_XGEN(b.x)], 1u);
            asm volatile("s_waitcnt vmcnt(0)" ::: "memory");
        } else {
            XB_SPIN(xb_ld(&bar[XB_XGEN(b.x)]) == gen, bar);
            __builtin_amdgcn_fence(__ATOMIC_ACQUIRE, "agent");
            asm volatile("s_waitcnt vmcnt(0)" ::: "memory");
        }
    }
    __syncthreads();
}


__device__ __forceinline__ void sample_outproj(const bf16_t* MIXp, const bf16_t* Wt, int K, const float* Xs  , float* Z, int gw, int NGW, int lane) {
    const int fr = lane & 15, g4 = lane >> 4;
    for (int task = gw; task < 16 * 64; task += NGW) {
        const int rt = task >> 6, ct = task & 63;
        const bf16_t* ap = MIXp + (size_t)(NP + rt * 16 + fr) * K + g4 * 8;
        const bf16_t* bp = Wt + (size_t)(ct * 16 + fr) * K + g4 * 8;
        f32x4 acc = (f32x4){0.f, 0.f, 0.f, 0.f};
#pragma unroll 8
        for (int ks = 0; ks < K / 32; ++ks) { const bf16x8 a = *(const bf16x8*)(ap + ks * 32), b = *(const bf16x8*)(bp + ks * 32);
            acc = __builtin_amdgcn_mfma_f32_16x16x32_bf16(a, b, acc, 0, 0, 0); }
#pragma unroll
        for (int r = 0; r < 4; ++r) { const size_t os = (size_t)(rt * 16 + g4 * 4 + r) * DM + ct * 16 + fr; Z[(size_t)NP * DM + os] = Xs[os] * ALPHA + acc[r]; }
    }
}

#ifndef PHM
#define PHM 0xFFFF
#endif
#ifndef PHDUP
#define PHDUP 0
#endif
#define PH(b) for (int _r = 0; _r < ((((PHDUP) >> (b)) & 1) ? 2 : 1); ++_r) if constexpr (((PHM) >> (b)) & 1)
#ifndef SYNCDUP
#define SYNCDUP 0
#endif
#define GSYNC() do { for (int _q = 0; _q <= SYNCDUP; ++_q) xcd_barrier(xbar); } while (0)
__global__ void __launch_bounds__(512, 2) fwd_megakernel(Params p) {
    extern __shared__ __attribute__((aligned(16))) unsigned char lds_raw[];
    cg::grid_group grid = cg::this_grid();
    LAS unsigned char* lds = (LAS unsigned char*)lds_raw;
    const int G = gridDim.x, NGW = G * 8;
    const int wave_s = __builtin_amdgcn_readfirstlane(threadIdx.x >> 6);
#define LAUNDER() int wave_ = wave_s; asm volatile("" : "+s"(wave_)); const int lane = pg8_opaque_lane(), wave = wave_, gw = blockIdx.x * 8 + wave; (void)lane; (void)gw;
    unsigned char* ws = p.ws;
    float* Xf = (float*)(ws + WS_XF); bf16_t* Xb = (bf16_t*)(ws + WS_XB); bf16_t* Pm = (bf16_t*)(ws + WS_P);
    float* Z = (float*)(ws + WS_Z); bf16_t* MIX = (bf16_t*)(ws + WS_MIX);

    for (int u = wave_s * 64 + pg8_opaque_lane(); u < (LDS_BYTES - 131072) / 4; u += 512) ((LAS unsigned*)(lds + 131072))[u] = 0u;
    __syncthreads();
    XcdBarrier xbar = xcd_barrier_post((unsigned*)(p.ws + WS_CTL), (volatile LAS unsigned*)(lds + MISC_OFF) + 8, wave_s);
    PH(0) { LAUNDER(); phase0(p, lds, gw, NGW, wave, lane); }
    if (p.ws == nullptr) grid.sync();
    GSYNC();
#pragma unroll 1
    for (int li = 0; li < 4; ++li) {
        const int j = li >> 1;
        if ((li & 1) == 0) {
            PH(1) { pg8::Gemm g{Xb, (const bf16_t*)(ws + WS_WEI) + (size_t)j * EINP * 1024, MTOK, EINP, 1024}; pg8::StaticOrder S; S.init(MTOK, EINP, G, (int)blockIdx.x);
              pg8::EpiStoreBf16 E{Pm, EINP};
              pg8::gemm_phase<pg8::EpiStoreBf16, pg8::StaticOrder, true, true>(lds, g, S, E, wave_s); }
            GSYNC();
            PH(2) even_prep(p, j, lds, wave_s);
            GSYNC();
            PH(3) { LAUNDER(); even_scan(p, j, lds, gw, NGW, wave, lane); }
            GSYNC();
            PH(4) even_carry(p, j, lds, wave_s);
            GSYNC();
            PH(5) { LAUNDER(); even_fixup(p, j, lds, gw, NGW, wave, lane); }
            GSYNC();
            PH(6) { LAUNDER(); sample_outproj(MIX, (const bf16_t*)(ws + WS_WEO) + (size_t)j * 1024 * 1024, 1024, li == 0 ? p.in[1] : Xf + (size_t)NP * DM, Z, gw, NGW, lane); }
            PH(6) { pg8::Gemm g{MIX, (const bf16_t*)(ws + WS_WEO) + (size_t)j * 1024 * 1024, NP, 1024, 1024}; pg8::StaticOrder S; S.init(NP, 1024, G, (int)blockIdx.x);
              pg8::EpiResid E{li == 0 ? p.in[0] : Xf, Z};
              pg8::gemm_phase<pg8::EpiResid, pg8::StaticOrder, true, true>(lds, g, S, E, wave_s); }
            GSYNC();
        } else {
            PH(7) { pg8::Gemm g{Xb, (const bf16_t*)(ws + WS_WOI) + (size_t)j * OIN * 1024, MTOK, OIN, 1024}; pg8::StaticOrder S; S.init(MTOK, OIN, G, (int)blockIdx.x);
              pg8::EpiOddIn E{Pm, p.out, j};
              pg8::gemm_phase<pg8::EpiOddIn, pg8::StaticOrder, true, true>(lds, g, S, E, wave_s); }
            GSYNC();
            PH(8) { LAUNDER(); attn_prompt(p, j, lds, wave, lane); }
            PH(9) { LAUNDER(); attn_sample(p, j, lds, gw, NGW, wave, lane); }
            PH(10) { LAUNDER(); kv_copy(p, j, gw, NGW, lane); }
            GSYNC();
            PH(11) { LAUNDER(); attn_merge(p, gw, NGW, lane); }
            GSYNC();
            PH(12) { LAUNDER(); sample_outproj(MIX, (const bf16_t*)(ws + WS_WOO) + (size_t)j * 1024 * 512, 512, Xf + (size_t)NP * DM, Z, gw, NGW, lane); }
            PH(12) { pg8::Gemm g{MIX, (const bf16_t*)(ws + WS_WOO) + (size_t)j * 1024 * 512, NP, 1024, 512}; pg8::StaticOrder S; S.init(NP, 1024, G, (int)blockIdx.x);
              pg8::EpiResid E{Xf, Z};
              pg8::gemm_phase<pg8::EpiResid, pg8::StaticOrder, true, true>(lds, g, S, E, wave_s); }
            GSYNC();
        }
        PH(13) { LAUNDER(); ln_phase(Z, p.in[23] + li * DM, p.in[24] + li * DM, li == 3 ? p.out + O_Y : Xf, Xb, gw, NGW, lane); }
        if (li < 3) GSYNC();
    }
}

extern "C" void kernel_launch(void* const* d_in, const int* in_sizes, int n_in, void* d_out, int out_size, void* d_ws, size_t ws_size, hipStream_t stream) {
    static int grid_blocks = 0;
    if (grid_blocks == 0) {
        if (n_in != 25 || (size_t)out_size != O_END || ws_size < WS_END) { fprintf(stderr, "kernel_launch: unexpected shapes n_in %d out %d ws %zu\n", n_in, out_size, ws_size); grid_blocks = -1; return; }
        int dev = 0, cus = 0, per_cu = 0;
        hipGetDevice(&dev);
        hipDeviceGetAttribute(&cus, hipDeviceAttributeMultiprocessorCount, dev);
        if (hipFuncSetAttribute((const void*)fwd_megakernel, hipFuncAttributeMaxDynamicSharedMemorySize, LDS_BYTES) != hipSuccess) { fprintf(stderr, "kernel_launch: hipFuncSetAttribute failed\n"); grid_blocks = -1; return; }
        if (hipOccupancyMaxActiveBlocksPerMultiprocessor(&per_cu, (const void*)fwd_megakernel, 512, LDS_BYTES) != hipSuccess || per_cu < 1) { fprintf(stderr, "kernel_launch: occupancy query gave %d\n", per_cu); per_cu = 1; }
        (void)hipGetLastError();
        grid_blocks = cus * per_cu;
    }
    if (grid_blocks < 0) return;
    Params p{};
    for (int i = 0; i < 25; ++i) p.in[i] = (const float*)d_in[i];
    p.out = (float*)d_out; p.ws = (unsigned char*)d_ws;
    if (hipMemsetAsync((char*)d_ws + WS_CTL, 0, 16384, stream) != hipSuccess) { fprintf(stderr, "kernel_launch: memset failed\n"); return; }
    void* args[] = {&p};
    hipError_t e = hipLaunchCooperativeKernel((void*)fwd_megakernel, dim3(grid_blocks), dim3(512), args, LDS_BYTES, stream);
    if (e != hipSuccess) fprintf(stderr, "cooperative launch failed: %s (grid %d)\n", hipGetErrorString(e), grid_blocks);
}
```

```cpp
#include <hip/hip_runtime.h>
#include <hip/hip_cooperative_groups.h>
#include <cstdio>
#include <cstdint>
namespace cg = cooperative_groups;
__device__ __forceinline__ int pg8_opaque_lane() { unsigned m = ~0u; asm volatile("" : "+s"(m)); return (int)__builtin_amdgcn_mbcnt_hi(m, __builtin_amdgcn_mbcnt_lo(m, 0u)); }
namespace pg8 {
#define PG8_LAS __attribute__((address_space(3)))
typedef unsigned short bf16_t;
typedef short bf16x8 __attribute__((ext_vector_type(8)));
typedef float f32x4 __attribute__((ext_vector_type(4)));
typedef unsigned u32x4 __attribute__((ext_vector_type(4)));
constexpr int BM = 256, BK = 64, HALF = 128, HTB = HALF * BK * 2  , STAGE_BYTES = 8 * HTB, NXCD = 8, WGM = 8;

__host__ __device__ __forceinline__ int lds_byte(int r, int c) { const int st = (r >> 4) * 2 + (c >> 5), rr = r & 15, cc = c & 31, ob = rr * 64 + cc * 2; return st * 1024 + (ob ^ (((ob >> 9) & 1) << 5)); }
__host__ __device__ __forceinline__ void stage_rc(int b, int& R, int& C) { const int st = b / 1024, sb = b % 1024, swz = sb ^ (((sb >> 9) & 1) << 5); R = (st >> 1) * 16 + swz / 64; C = (st & 1) * 32 + (swz % 64) / 2; }
__host__ __device__ __forceinline__ int perm32(int rho) { const int n = rho >> 4, i = rho & 15; return 8 * (i >> 2) + 4 * n + (i & 3); }

struct Unit { int pm, pn; };
struct Gemm { const bf16_t* A; const bf16_t* Bt; int M, N, K; };

struct StaticOrder {
    int nM, nN, nwg, G, c;
    __host__ __device__ void init(int M, int N, int G_, int c_) { nM = M / BM; nN = N / BM; nwg = nM * nN; G = G_; c = c_; }
    __host__ __device__ bool next(int i, Unit& u) const {
        const long L = (long)i * G + c; if (L >= nwg) return false;
        int wgid = (int)L; { const int q = nwg / NXCD, r = nwg % NXCD, xcd = wgid % NXCD, off = wgid / NXCD; wgid = (xcd < r ? xcd * (q + 1) : r * (q + 1) + (xcd - r) * q) + off; }
        const int nig = WGM * nN, gid = wgid / nig, fm = gid * WGM, gsz = (nM - fm) < WGM ? (nM - fm) : WGM;
        u.pm = fm + ((wgid % nig) % gsz); u.pn = (wgid % nig) / gsz; return true;
    }
    __device__ __forceinline__ void a_ready(const Unit&) const {}
    __device__ __forceinline__ void done(const Unit&) const {}
};

__device__ __forceinline__ unsigned cvt_pk_bf16(float lo, float hi) { unsigned r; asm volatile("v_cvt_pk_bf16_f32 %0, %1, %2" : "=v"(r) : "v"(lo), "v"(hi)); return r; }
typedef float f32x2 __attribute__((ext_vector_type(2)));
template <class Epi, class Sched, bool ALIGN_EPI = false, bool SP2 = false>
__device__ __forceinline__ void gemm_phase(PG8_LAS unsigned char* lds, const Gemm g, const Sched& S, const Epi& E, const int wave_s) {
    int wid_ = wave_s; asm volatile("" : "+s"(wid_));
    const int lane = pg8_opaque_lane(), wid = wid_, tid = wid_ * 64 + lane, wr = wid >> 2, wc = wid & 3, fr = lane & 15, fq = lane >> 4;
    const int K = g.K, nt = K / BK;
    unsigned voffA[2], voffB[2];
#pragma unroll
    for (int i = 0; i < 2; ++i) { int R, C; stage_rc(tid * 16 + i * 8192, R, C); const int Rb = Epi::PERM ? ((R & ~31) + perm32(R & 31)) : R;
        voffA[i] = (unsigned)(R * K + C) * 2u; voffB[i] = (unsigned)(Rb * K + C) * 2u; }
    const size_t kstep = (size_t)(BK * 2);
    const size_t hstep = (size_t)HALF * K * 2;
    const size_t tstep = 2 * hstep;
    const unsigned ldsw = (unsigned)wid * 1024u;
    const int aoff = lds_byte(wr * 64 + fr, fq * 8), boff = lds_byte(wc * 32 + fr, fq * 8);
#define PG8_SA(b, h) (((b) * 2 + (h)) * HTB)
#define PG8_SB(b, h) ((4 + (b) * 2 + (h)) * HTB)
#define PG8_STAGE(bufoff, gbase, voff) do { _Pragma("unroll") for (int _i = 0; _i < 2; ++_i) \
        __builtin_amdgcn_global_load_lds((const unsigned*)((const char*)(gbase) + (voff)[_i]), (PG8_LAS unsigned*)(lds + (bufoff) + ldsw + _i * 8192), 16, 0, 0); } while (0)
#define PG8_LDA(dst, b, h) do { _Pragma("unroll") for (int m = 0; m < 4; ++m) _Pragma("unroll") for (int k = 0; k < 2; ++k) dst[m][k] = *(const PG8_LAS bf16x8*)(lds + PG8_SA(b, h) + aoff + m * 2048 + k * 1024); } while (0)
#define PG8_LDB(dst, b, h) do { _Pragma("unroll") for (int n = 0; n < 2; ++n) _Pragma("unroll") for (int k = 0; k < 2; ++k) dst[n][k] = *(const PG8_LAS bf16x8*)(lds + PG8_SB(b, h) + boff + n * 2048 + k * 1024); } while (0)
#define PG8_MMA(ai, bj, At, Bt) do { __builtin_amdgcn_s_setprio(1); _Pragma("unroll") for (int m = 0; m < 4; ++m) _Pragma("unroll") for (int n = 0; n < 2; ++n) _Pragma("unroll") for (int k = 0; k < 2; ++k) \
        acc[ai][bj][m][n] = __builtin_amdgcn_mfma_f32_16x16x32_bf16(Bt[n][k], At[m][k], acc[ai][bj][m][n], 0, 0, 0); __builtin_amdgcn_s_setprio(0); } while (0)
#define PG8_WAIT_V(n) asm volatile("s_waitcnt vmcnt(" #n ")" ::: "memory")
#define PG8_WAIT_L(n) asm volatile("s_waitcnt lgkmcnt(" #n ")" ::: "memory")
#define PG8_BAR __builtin_amdgcn_s_barrier()
#define PG8_SCHED __builtin_amdgcn_sched_barrier(0)
    Unit cur, nxt; int ui = 0;
    if (!S.next(0, cur)) return;
    f32x4 acc[2][2][4][2];
#pragma unroll
    for (int a = 0; a < 2; ++a)
#pragma unroll
        for (int b = 0; b < 2; ++b)
#pragma unroll
            for (int m = 0; m < 4; ++m)
#pragma unroll
                for (int n = 0; n < 2; ++n) acc[a][b][m][n] = (f32x4){0.f, 0.f, 0.f, 0.f};
    bf16x8 At[4][2], B0[2][2], B1[2][2];
    const char* cA = (const char*)g.A + (size_t)cur.pm * tstep; const char* cB = (const char*)g.Bt + (size_t)cur.pn * tstep;
    S.a_ready(cur);
    if constexpr (SP2) {
        PG8_STAGE(PG8_SB(0, 0), cB, voffB); PG8_STAGE(PG8_SB(0, 1), cB + hstep, voffB); PG8_STAGE(PG8_SA(0, 0), cA, voffA); PG8_STAGE(PG8_SA(0, 1), cA + hstep, voffA);
        if (wr == 1) PG8_BAR;
        PG8_WAIT_V(2); PG8_BAR;
        PG8_STAGE(PG8_SB(1, 0), cB + kstep, voffB); PG8_STAGE(PG8_SA(1, 0), cA + kstep, voffA); PG8_STAGE(PG8_SB(1, 1), cB + hstep + kstep, voffB);
        PG8_WAIT_V(6); PG8_BAR;
    } else {
        PG8_STAGE(PG8_SB(0, 0), cB, voffB); PG8_STAGE(PG8_SA(0, 0), cA, voffA); PG8_STAGE(PG8_SB(0, 1), cB + hstep, voffB); PG8_STAGE(PG8_SA(0, 1), cA + hstep, voffA);
        if (wr == 1) PG8_BAR;
        PG8_WAIT_V(4); PG8_BAR;
        PG8_STAGE(PG8_SB(1, 0), cB + kstep, voffB); PG8_STAGE(PG8_SA(1, 0), cA + kstep, voffA); PG8_STAGE(PG8_SB(1, 1), cB + hstep + kstep, voffB);
        PG8_WAIT_V(6); PG8_BAR;
    }
    for (;;) {
        const bool has_next = S.next(ui + 1, nxt);
        const char* nA = has_next ? (const char*)g.A + (size_t)nxt.pm * tstep : cA; const char* nB = has_next ? (const char*)g.Bt + (size_t)nxt.pn * tstep : cB;
        for (int t = 0; t < nt; t += 2) {
            const bool last = (t == nt - 2);
            const char* a1 = cA + (size_t)(t + 1) * kstep;
            const char* a2 = last ? nA : cA + (size_t)(t + 2) * kstep; const char* b2 = last ? nB : cB + (size_t)(t + 2) * kstep;
            const char* a3 = a2 + kstep; const char* b3 = b2 + kstep;
            if (last && has_next) S.a_ready(nxt);
            if constexpr (SP2) {
            PG8_LDB(B0, 0, 0); PG8_LDB(B1, 0, 1); PG8_SCHED; PG8_LDA(At, 0, 0); PG8_STAGE(PG8_SA(1, 1), a1 + hstep, voffA);
            PG8_WAIT_V(8); PG8_WAIT_L(0); PG8_BAR; PG8_MMA(0, 0, At, B0); PG8_MMA(0, 1, At, B1); PG8_BAR; PG8_SCHED;
            PG8_LDA(At, 0, 1); PG8_STAGE(PG8_SB(0, 0), b2, voffB); PG8_STAGE(PG8_SB(0, 1), b2 + hstep, voffB); PG8_STAGE(PG8_SA(0, 0), a2, voffA);
            PG8_WAIT_V(8); PG8_WAIT_L(0); PG8_BAR; PG8_MMA(1, 0, At, B0); PG8_MMA(1, 1, At, B1); PG8_BAR; PG8_SCHED;
            PG8_LDB(B0, 1, 0); PG8_LDB(B1, 1, 1); PG8_SCHED; PG8_LDA(At, 1, 0); PG8_STAGE(PG8_SA(0, 1), a2 + hstep, voffA);
            PG8_WAIT_V(8); PG8_WAIT_L(0); PG8_BAR; PG8_MMA(0, 0, At, B0); PG8_MMA(0, 1, At, B1); PG8_BAR; PG8_SCHED;
            PG8_LDA(At, 1, 1); PG8_STAGE(PG8_SB(1, 0), b3, voffB); PG8_STAGE(PG8_SB(1, 1), b3 + hstep, voffB); PG8_STAGE(PG8_SA(1, 0), a3, voffA);
            PG8_WAIT_V(8); PG8_WAIT_L(0); PG8_BAR; PG8_MMA(1, 0, At, B0); PG8_MMA(1, 1, At, B1); PG8_BAR; PG8_SCHED;
            } else {
            PG8_LDB(B0, 0, 0); PG8_SCHED; PG8_LDA(At, 0, 0); PG8_STAGE(PG8_SA(1, 1), a1 + hstep, voffA);
            PG8_WAIT_L(8); PG8_BAR; PG8_WAIT_L(0); PG8_MMA(0, 0, At, B0); PG8_BAR; PG8_SCHED;
            PG8_LDB(B1, 0, 1); PG8_STAGE(PG8_SB(0, 0), b2, voffB);
            PG8_BAR; PG8_WAIT_L(0); PG8_MMA(0, 1, At, B1); PG8_BAR;
            PG8_LDA(At, 0, 1); PG8_STAGE(PG8_SA(0, 0), a2, voffA);
            PG8_BAR; PG8_WAIT_L(0); PG8_MMA(1, 0, At, B0); PG8_BAR; PG8_SCHED;
            PG8_STAGE(PG8_SB(0, 1), b2 + hstep, voffB);
            PG8_WAIT_V(6); PG8_BAR; PG8_MMA(1, 1, At, B1); PG8_BAR;
            PG8_LDB(B0, 1, 0); PG8_SCHED; PG8_LDA(At, 1, 0); PG8_STAGE(PG8_SA(0, 1), a2 + hstep, voffA);
            PG8_WAIT_L(8); PG8_BAR; PG8_WAIT_L(0); PG8_MMA(0, 0, At, B0); PG8_BAR; PG8_SCHED;
            PG8_LDB(B1, 1, 1); PG8_STAGE(PG8_SB(1, 0), b3, voffB);
            PG8_BAR; PG8_WAIT_L(0); PG8_MMA(0, 1, At, B1); PG8_BAR;
            PG8_LDA(At, 1, 1); PG8_STAGE(PG8_SA(1, 0), a3, voffA);
            PG8_BAR; PG8_WAIT_L(0); PG8_MMA(1, 0, At, B0); PG8_BAR; PG8_SCHED;
            PG8_STAGE(PG8_SB(1, 1), b3 + hstep, voffB);
            PG8_WAIT_V(6); PG8_BAR; PG8_MMA(1, 1, At, B1); PG8_BAR;
            }
        }
        if constexpr (ALIGN_EPI) { if (wr == 0) PG8_BAR; }
        if constexpr (!Epi::AFTER_DRAIN) { E(acc, cur, wr, wc, fr, fq); S.done(cur); }
        if (!has_next) break;
#pragma unroll
        for (int a = 0; a < 2; ++a)
#pragma unroll
            for (int b = 0; b < 2; ++b)
#pragma unroll
                for (int m = 0; m < 4; ++m)
#pragma unroll
                    for (int n = 0; n < 2; ++n) acc[a][b][m][n] = (f32x4){0.f, 0.f, 0.f, 0.f};
        cur = nxt; cA = nA; cB = nB; ++ui;
        if constexpr (ALIGN_EPI) { if (wr == 1) PG8_BAR; }
    }
    PG8_WAIT_V(0);
    if constexpr (!ALIGN_EPI) { if (wr == 0) PG8_BAR; }
    PG8_BAR;
    if constexpr (Epi::AFTER_DRAIN) { E.fused(acc, cur, wr, wc, fr, fq, lds, wid, lane); S.done(cur); }
#undef PG8_SA
#undef PG8_SB
#undef PG8_STAGE
#undef PG8_LDA
#undef PG8_LDB
#undef PG8_MMA
#undef PG8_WAIT_V
#undef PG8_WAIT_L
#undef PG8_BAR
#undef PG8_SCHED
}
}

#define LAS __attribute__((address_space(3)))
#define CAS __attribute__((address_space(4)))
typedef unsigned short bf16_t;
typedef float f32x4 __attribute__((ext_vector_type(4)));
typedef float f32x2 __attribute__((ext_vector_type(2)));
typedef unsigned u32x4 __attribute__((ext_vector_type(4)));
typedef unsigned u32x2 __attribute__((ext_vector_type(2)));
typedef short bf16x8 __attribute__((ext_vector_type(8)));
typedef CAS const float cfloat;

constexpr int DM = 1024, NP = 16384, NS = 256, MTOK = NP + NS;
constexpr int SEQ = 2048, PB = 8, SB = 32, ST = 8;
constexpr int EIN = 4224, EINP = 4352, OIN = 5120, ASW = 1664;
constexpr int CH = 64, NCH = SEQ / CH, TS = 4;
constexpr float ALPHA = 1.6817928305074292f;

constexpr size_t O_Y = 0;
constexpr size_t O_RWKV_P = (size_t)MTOK * DM;
constexpr size_t O_RWKV_S = O_RWKV_P + 2ull * 8 * 8 * 4096;
constexpr size_t O_SH_P = O_RWKV_S + 2ull * 32 * 8 * 4096;
constexpr size_t O_SH_S = O_SH_P + 2ull * 8 * ASW;
constexpr size_t O_CV_P = O_SH_S + 2ull * 32 * ASW;
constexpr size_t O_CV_S = O_CV_P + 2ull * 8 * 2 * 512;
constexpr size_t O_KV128_P = O_CV_S + 2ull * 32 * 2 * 512;
constexpr size_t O_KV128_S = O_KV128_P + 2ull * 8 * 128 * 1024;
constexpr size_t O_KV512_P = O_KV128_S + 2ull * 32 * 128 * 1024;
constexpr size_t O_KV512_S = O_KV512_P + 2ull * 8 * 512 * 1024;
constexpr size_t O_KV2048_P = O_KV512_S + 2ull * 32 * 512 * 1024;
constexpr size_t O_KV2048_S = O_KV2048_P + 2ull * 8 * 2048 * 1024;
constexpr size_t O_END = O_KV2048_S + 2ull * 32 * 2048 * 1024;
static_assert(O_END == 240076800ull, "output size");

constexpr size_t MiB = 1ull << 20;
constexpr size_t WS_WEI = 0;
constexpr size_t WS_WEO = WS_WEI + 2ull * EINP * 1024 * 2;
constexpr size_t WS_WOI = WS_WEO + 2ull * 1024 * 1024 * 2;
constexpr size_t WS_WOO = WS_WOI + 2ull * OIN * 1024 * 2;
constexpr size_t WS_XF = 64 * MiB;
constexpr size_t WS_XB = WS_XF + 66 * MiB;
constexpr size_t WS_P = WS_XB + 34 * MiB;
constexpr size_t WS_Z = WS_P + 164 * MiB;
constexpr size_t WS_MIX = WS_Z + 66 * MiB;
constexpr size_t WS_SC = WS_MIX + 34 * MiB;
constexpr size_t SC_STRIDE = (size_t)MTOK * 512 * 4;
constexpr size_t WS_Q = WS_SC + 6 * SC_STRIDE;
constexpr size_t SET_STRIDE = 7 * SC_STRIDE;
constexpr size_t WS_BON = WS_SC + 2 * SET_STRIDE + MiB;
constexpr size_t WS_YL = WS_BON + MiB;
constexpr size_t WS_LC = WS_YL + 34 * MiB;
constexpr size_t WS_PC = WS_LC + 34 * MiB;
constexpr size_t WS_SST = WS_PC + 34 * MiB;
constexpr size_t WS_OG = WS_SST + 34 * MiB;
constexpr size_t WS_LSE = WS_OG + 49 * MiB;
constexpr size_t WS_CTL = WS_LSE + 2 * MiB;
constexpr size_t WS_END = WS_CTL + MiB;

constexpr int LDS_BYTES = 147456, MISC_OFF = 131072 + 320;

struct Params { const float* in[25]; float* out; unsigned char* ws; };

__device__ __forceinline__ float bf2f(bf16_t h) { return __uint_as_float(((unsigned)h) << 16); }
__device__ __forceinline__ unsigned f2bf(float f) { unsigned u = __float_as_uint(f); return (u + 0x7fffu + ((u >> 16) & 1u)) >> 16; }
__device__ __forceinline__ unsigned pk2(float lo, float hi) { return f2bf(lo) | (f2bf(hi) << 16); }
__device__ __forceinline__ float wave_sum(float v) {
#define DPPADD_(ctrl, rm, bc) v += __builtin_bit_cast(float, __builtin_amdgcn_update_dpp(0, __builtin_bit_cast(int, v), ctrl, rm, 0xf, bc))
    DPPADD_(0x111, 0xf, true); DPPADD_(0x112, 0xf, true); DPPADD_(0x114, 0xf, true); DPPADD_(0x118, 0xf, true);
    DPPADD_(0x142, 0xa, false); DPPADD_(0x143, 0xc, false);
#undef DPPADD_
    return __builtin_bit_cast(float, __builtin_amdgcn_readlane(__builtin_bit_cast(int, v), 63));
}
__device__ __forceinline__ float row16_sum(float v) {
#define ROR_(n) v += __builtin_bit_cast(float, __builtin_amdgcn_update_dpp(0, __builtin_bit_cast(int, v), 0x120 + n, 0xf, 0xf, false))
    ROR_(8); ROR_(4); ROR_(2); ROR_(1);
#undef ROR_
    return v;
}
__device__ __forceinline__ void swap16_(float& a, float& b) { asm volatile("s_nop 1\n\tv_permlane16_swap_b32 %0, %1" : "+v"(a), "+v"(b)); }
__device__ __forceinline__ void swap32_(float& a, float& b) { asm volatile("s_nop 1\n\tv_permlane32_swap_b32 %0, %1" : "+v"(a), "+v"(b)); }
__device__ __forceinline__ float xsum4(float a) {
    float p = a, q = a; swap16_(p, q); float s = p + q;
    float u = s, w = s; swap32_(u, w); return u + w;
}
__device__ __forceinline__ float xmax4(float a) {
    float p = a, q = a; swap16_(p, q); float s = fmaxf(p, q);
    float u = s, w = s; swap32_(u, w); return fmaxf(u, w);
}
__device__ __forceinline__ float wave_max(float v) {
#define DPPMAX_(ctrl, rm) v = fmaxf(v, __builtin_bit_cast(float, __builtin_amdgcn_update_dpp(__builtin_bit_cast(int, v), __builtin_bit_cast(int, v), ctrl, rm, 0xf, false)))
    DPPMAX_(0x111, 0xf); DPPMAX_(0x112, 0xf); DPPMAX_(0x114, 0xf); DPPMAX_(0x118, 0xf); DPPMAX_(0x142, 0xa); DPPMAX_(0x143, 0xc);
#undef DPPMAX_
    return __builtin_bit_cast(float, __builtin_amdgcn_readlane(__builtin_bit_cast(int, v), 63));
}
__device__ __forceinline__ float silu(float x) { return x / (1.f + __expf(-x)); }
__device__ __forceinline__ float sigmoidf(float x) { return 1.f / (1.f + __expf(-x)); }

__device__ __forceinline__ float fma_s(float a, float b, float c) { float d; asm("v_fma_f32 %0, %1, %2, %3" : "=v"(d) : "v"(a), "v"(b), "v"(c)); return d; }
__device__ __forceinline__ float fnma_s(float a, float b, float c) { float d; asm("v_fma_f32 %0, -%1, %2, %3" : "=v"(d) : "v"(a), "v"(b), "v"(c)); return d; }
__device__ __forceinline__ float mul_s(float a, float b) { float d; asm("v_mul_f32 %0, %1, %2" : "=v"(d) : "v"(a), "v"(b)); return d; }

namespace pg8 {
struct EpiStoreBf16 {
    static constexpr bool PERM = true, AFTER_DRAIN = false;
    bf16_t* O; int ldc;
    __device__ __forceinline__ void operator()(const f32x4 (&acc)[2][2][4][2], const Unit& u, int wr, int wc, int fr, int fq) const {
        const int row0 = u.pm * BM + wr * 64 + fr, col0 = u.pn * BM + wc * 32 + 8 * fq;
#pragma unroll
        for (int ai = 0; ai < 2; ++ai)
#pragma unroll
            for (int m = 0; m < 4; ++m) { bf16_t* rowp = O + (size_t)(row0 + ai * HALF + m * 16) * ldc + col0;
#pragma unroll
                for (int bj = 0; bj < 2; ++bj) { const f32x4 v0 = acc[ai][bj][m][0], v1 = acc[ai][bj][m][1];
                    u32x4 w; w.x = cvt_pk_bf16(v0[0], v0[1]); w.y = cvt_pk_bf16(v0[2], v0[3]); w.z = cvt_pk_bf16(v1[0], v1[1]); w.w = cvt_pk_bf16(v1[2], v1[3]);
                    *(u32x4*)(rowp + bj * HALF) = w; } }
    }
};
struct EpiOddIn {
    static constexpr bool PERM = true, AFTER_DRAIN = false;
    bf16_t* O; float* out; int j;
    __device__ __forceinline__ void operator()(const f32x4 (&acc)[2][2][4][2], const Unit& u, int wr, int wc, int fr, int fq) const {
        const int row0 = u.pm * BM + wr * 64 + fr, colt = u.pn * BM, col0 = colt + wc * 32 + 8 * fq;
        const int type = colt / 1536, rem = colt - type * 1536, g = rem >> 9, cbase = (rem & 511) + wc * 32 + 8 * fq;
        const int W = g == 0 ? 128 : (g == 1 ? 512 : 2048);
        const size_t offp = (g == 0 ? O_KV128_P : (g == 1 ? O_KV512_P : O_KV2048_P)) + (size_t)j * PB * W * 1024;
        const size_t offs = (g == 0 ? O_KV128_S : (g == 1 ? O_KV512_S : O_KV2048_S)) + (size_t)j * SB * W * 1024;
        const bool iskv = (type == 1 || type == 2);
#pragma unroll
        for (int ai = 0; ai < 2; ++ai)
#pragma unroll
            for (int m = 0; m < 4; ++m) { const int row = row0 + ai * HALF + m * 16; bf16_t* rowp = O + (size_t)row * OIN + col0;
                bool wr_kv = false; size_t doff = 0;
                if (iskv) {
                    if (row < NP) { const int b = row >> 11, t = row & 2047, r = t - (SEQ - W); if (r >= 0) { wr_kv = true; doff = offp + ((size_t)(b * W + r) * 2 + (type - 1)) * 512 + cbase; } }
                    else { const int s = row - NP, b = s >> 3, t = s & 7, r = W - 8 + t; wr_kv = true; doff = offs + ((size_t)(b * W + r) * 2 + (type - 1)) * 512 + cbase; }
                }
#pragma unroll
                for (int bj = 0; bj < 2; ++bj) { const f32x4 v0 = acc[ai][bj][m][0], v1 = acc[ai][bj][m][1];
                    u32x4 w; w.x = cvt_pk_bf16(v0[0], v0[1]); w.y = cvt_pk_bf16(v0[2], v0[3]); w.z = cvt_pk_bf16(v1[0], v1[1]); w.w = cvt_pk_bf16(v1[2], v1[3]);
                    *(u32x4*)(rowp + bj * HALF) = w;
                    if (wr_kv) { *(f32x4*)(out + doff + bj * HALF) = v0; *(f32x4*)(out + doff + bj * HALF + 4) = v1; } } }
    }
};
struct EpiResid {
    static constexpr bool PERM = false, AFTER_DRAIN = false;
    const float* X; float* Z;
    __device__ __forceinline__ void operator()(const f32x4 (&acc)[2][2][4][2], const Unit& u, int wr, int wc, int fr, int fq) const {
        const int row0 = u.pm * BM + wr * 64 + fr, col0 = u.pn * BM + wc * 32 + 4 * fq;
#pragma unroll
        for (int ai = 0; ai < 2; ++ai)
#pragma unroll
            for (int m = 0; m < 4; ++m) { const size_t off = (size_t)(row0 + ai * HALF + m * 16) * DM + col0;
#pragma unroll
                for (int bj = 0; bj < 2; ++bj)
#pragma unroll
                    for (int n = 0; n < 2; ++n) { const f32x4 x = *(const f32x4*)(X + off + bj * HALF + n * 16);
                        *(f32x4*)(Z + off + bj * HALF + n * 16) = x * ALPHA + acc[ai][bj][m][n]; } }
    }
};
}

__device__ __forceinline__ void p0_transpose_item(const float* W, int K, int N, bf16_t* WT, LAS float* scr, int item, int lane) {
    const int nblk = N / 32, kb = item / nblk, nb = item % nblk, k0 = 64 * kb, n0 = 32 * nb;
    float tv[32];
#pragma unroll
    for (int i = 0; i < 32; ++i) tv[i] = W[(size_t)(k0 + 2 * i + (lane >> 5)) * N + n0 + (lane & 31)];
#pragma unroll
    for (int i = 0; i < 32; ++i) scr[(2 * i + (lane >> 5)) * 33 + (lane & 31)] = tv[i];
    asm volatile("s_waitcnt lgkmcnt(0)" ::: "memory");
    const int c = lane & 7;
#pragma unroll
    for (int j = 0; j < 4; ++j) { const int n = (lane >> 3) + 8 * j; const LAS float* s = scr + (8 * c) * 33 + n;
        u32x4 o; o.x = pk2(s[0 * 33], s[1 * 33]); o.y = pk2(s[2 * 33], s[3 * 33]); o.z = pk2(s[4 * 33], s[5 * 33]); o.w = pk2(s[6 * 33], s[7 * 33]);
        *(u32x4*)(WT + (size_t)(n0 + n) * K + k0 + 8 * c) = o; }
    asm volatile("s_waitcnt lgkmcnt(0)" ::: "memory");
}

__device__ __forceinline__ void phase0(const Params& p, LAS unsigned char* lds, int gw, int NGW, int wave, int lane) {
    LAS float* scr = (LAS float*)(lds + wave * 16384);
    unsigned char* ws = p.ws;
    constexpr int I_EI = (1024 / 64) * (EIN / 32), I_EO = (1024 / 64) * (1024 / 32), I_OI = (1024 / 64) * (OIN / 32), I_OO = (512 / 64) * (1024 / 32);
    constexpr int NIT = 2 * (I_EI + I_EO + I_OI + I_OO);
    for (int it = gw; it < NIT; it += NGW) {
        int r = it;
        if (r < 2 * I_EI) { const int j = r / I_EI; p0_transpose_item(p.in[8] + (size_t)j * 1024 * EIN, 1024, EIN, (bf16_t*)(ws + WS_WEI) + (size_t)j * EINP * 1024, scr, r % I_EI, lane); continue; } r -= 2 * I_EI;
        if (r < 2 * I_EO) { const int j = r / I_EO; p0_transpose_item(p.in[9] + (size_t)j * 1024 * 1024, 1024, 1024, (bf16_t*)(ws + WS_WEO) + (size_t)j * 1024 * 1024, scr, r % I_EO, lane); continue; } r -= 2 * I_EO;
        if (r < 2 * I_OI) { const int j = r / I_OI; p0_transpose_item(p.in[21] + (size_t)j * 1024 * OIN, 1024, OIN, (bf16_t*)(ws + WS_WOI) + (size_t)j * OIN * 1024, scr, r % I_OI, lane); continue; } r -= 2 * I_OI;
        { const int j = r / I_OO; p0_transpose_item(p.in[22] + (size_t)j * 512 * 1024, 512, 1024, (bf16_t*)(ws + WS_WOO) + (size_t)j * 1024 * 512, scr, r % I_OO, lane); }
    }
    for (int i = gw * 64 + lane; i < 2 * 16384; i += NGW * 64) { const int j = i >> 14, o = i & 16383;
        *((u32x4*)((bf16_t*)(ws + WS_WEI) + (size_t)j * EINP * 1024 + (size_t)EIN * 1024) + o) = (u32x4){0u, 0u, 0u, 0u}; }
    bf16_t* Xb = (bf16_t*)(ws + WS_XB);
    for (size_t i0 = (size_t)gw * 256 + lane; i0 < (size_t)MTOK * 256; i0 += (size_t)NGW * 256) {
        f32x4 v[4];
#pragma unroll
        for (int u = 0; u < 4; ++u) { const size_t i = i0 + u * 64; if (i < (size_t)MTOK * 256) v[u] = (i < (size_t)NP * 256) ? ((const f32x4*)p.in[0])[i] : ((const f32x4*)p.in[1])[i - (size_t)NP * 256]; }
#pragma unroll
        for (int u = 0; u < 4; ++u) { const size_t i = i0 + u * 64; if (i < (size_t)MTOK * 256) { u32x2 w; w.x = pk2(v[u][0], v[u][1]); w.y = pk2(v[u][2], v[u][3]); ((u32x2*)Xb)[i] = w; } }
    }
}

__device__ __forceinline__ void ln_phase(const float* Z, const float* g, const float* b, float* Xf, bf16_t* Xb, int gw, int NGW, int lane) {
    f32x4 gv[4], bv[4];
#pragma unroll
    for (int j = 0; j < 4; ++j) { gv[j] = ((const f32x4*)g)[64 * j + lane]; bv[j] = ((const f32x4*)b)[64 * j + lane]; }
    f32x4 nx[4];
    if (gw < MTOK) {
#pragma unroll
        for (int j = 0; j < 4; ++j) nx[j] = ((const f32x4*)(Z + (size_t)gw * DM))[64 * j + lane];
    }
    for (int m = gw; m < MTOK; m += NGW) {
        f32x4 v[4]; float s = 0.f;
#pragma unroll
        for (int j = 0; j < 4; ++j) v[j] = nx[j];
        if (m + NGW < MTOK) {
#pragma unroll
            for (int j = 0; j < 4; ++j) nx[j] = ((const f32x4*)(Z + (size_t)(m + NGW) * DM))[64 * j + lane];
        }
#pragma unroll
        for (int j = 0; j < 4; ++j) s += (v[j][0] + v[j][1]) + (v[j][2] + v[j][3]);
        const float mean = wave_sum(s) * (1.f / DM); float s2 = 0.f;
#pragma unroll
        for (int j = 0; j < 4; ++j) { v[j] = v[j] - mean; s2 += (v[j][0] * v[j][0] + v[j][1] * v[j][1]) + (v[j][2] * v[j][2] + v[j][3] * v[j][3]); }
        const float rstd = 1.f / sqrtf(wave_sum(s2) * (1.f / DM) + 1e-5f);
        f32x4* xo = (f32x4*)(Xf + (size_t)m * DM) + lane; u32x2* xb = (u32x2*)(Xb + (size_t)m * DM) + lane;
#pragma unroll
        for (int j = 0; j < 4; ++j) { const f32x4 o = v[j] * rstd * gv[j] + bv[j]; xo[64 * j] = o;
            u32x2 w; w.x = pk2(o[0], o[1]); w.y = pk2(o[2], o[3]); xb[64 * j] = w; }
    }
}

__device__ __forceinline__ void even_prep(const Params& p, int j, LAS unsigned char* lds, const int wave_s) {
    const int lane = pg8_opaque_lane(), wave = wave_s, tid = wave_s * 64 + lane, fr = lane & 15, g4 = lane >> 4;
    size_t zoff = 0; asm volatile("" : "+s"(zoff));
    unsigned char* ws = p.ws + zoff;
    unsigned char* wss = ws + (size_t)j * SET_STRIDE;
    const bf16_t* P = (const bf16_t*)(ws + WS_P);
    float* SR = (float*)(wss + WS_SC); float* SW = (float*)(wss + WS_SC + SC_STRIDE); float* SK = (float*)(wss + WS_SC + 2 * SC_STRIDE);
    float* SV = (float*)(wss + WS_SC + 3 * SC_STRIDE); float* SKK = (float*)(wss + WS_SC + 4 * SC_STRIDE); float* SBB = (float*)(wss + WS_SC + 5 * SC_STRIDE);
    float* BON = (float*)(ws + WS_BON); bf16_t* MIX = (bf16_t*)(ws + WS_MIX);
    const float* mu = p.in[10] + j * ASW;
    const float* sshift = p.in[3] + (size_t)j * SB * ASW;
    const float* sconv = p.in[4] + (size_t)j * SB * 2 * 512;
    const int G = gridDim.x, per = (MTOK + G - 1) / G, n0 = blockIdx.x * per, n1 = min(MTOK, n0 + per);
#define ROWC(r) ((size_t)((r) < 0 ? 0 : ((r) > MTOK - 1 ? MTOK - 1 : (r))) * EINP)
    LAS bf16_t* Alds = (LAS bf16_t*)lds;
    LAS float* DW = (LAS float*)(lds + 16384 + wave * 8192);
    LAS float* DA = DW + 1024;
    bf16x8 wf[4][2], af[4][2];
#pragma unroll
    for (int nt = 0; nt < 4; ++nt)
#pragma unroll
        for (int ks = 0; ks < 2; ++ks)
#pragma unroll
            for (int e = 0; e < 8; ++e) { const size_t o = (size_t)(j * 64 + ks * 32 + g4 * 8 + e) * 512 + wave * 64 + nt * 16 + fr;
                wf[nt][ks][e] = (short)f2bf(p.in[12][o]); af[nt][ks][e] = (short)f2bf(p.in[14][o]); }
    const float mu_r = mu[tid], mu_k = mu[512 + tid], mu_v = mu[1024 + tid], mu_l = tid < 128 ? mu[1536 + tid] : 0.f;
    const float w0 = p.in[11][j * 512 + tid], a0 = p.in[13][j * 512 + tid], k_k = p.in[15][j * 512 + tid], k_a = p.in[16][j * 512 + tid], r_k = p.in[17][j * 512 + tid];
    const float cw0 = p.in[20][(j * 3 + 0) * 512 + tid], cw1 = p.in[20][(j * 3 + 1) * 512 + tid], cw2 = p.in[20][(j * 3 + 2) * 512 + tid];
    int par = 0;
    for (int nb = n0; nb < n1; nb += 16, par ^= 1) {
        LAS bf16_t* Ab = Alds + par * (16 * 136);
        if (tid < 128) {
            float cl[17];
#pragma unroll
            for (int i = 0; i < 17; ++i) cl[i] = bf2f(P[ROWC(nb - 1 + i) + 1536 + tid]);
#pragma unroll
            for (int i = 0; i < 16; ++i) { const int n = nb + i; const bool samp = n >= NP; const int t = samp ? ((n - NP) & 7) : (n & 2047), b = samp ? ((n - NP) >> 3) : 0;
                float ql = cl[i]; if (t == 0) ql = (samp && n < MTOK) ? sshift[b * ASW + 1536 + tid] : 0.f;
                float v = cl[i + 1] + (ql - cl[i + 1]) * mu_l; if (tid < 64) v = 1.f - 2.f * __builtin_amdgcn_rcpf(1.f + __expf(2.f * v));
                Ab[i * 136 + tid] = (bf16_t)f2bf(v); }
        }
        __syncthreads();
        {
            const bf16x8 aw0 = *(const LAS bf16x8*)(Ab + fr * 136 + g4 * 8), aw1 = *(const LAS bf16x8*)(Ab + fr * 136 + 32 + g4 * 8);
            const bf16x8 aa0 = *(const LAS bf16x8*)(Ab + fr * 136 + 64 + g4 * 8), aa1 = *(const LAS bf16x8*)(Ab + fr * 136 + 96 + g4 * 8);
#pragma unroll
            for (int nt = 0; nt < 4; ++nt) {
                f32x4 dw = (f32x4){0.f, 0.f, 0.f, 0.f}, da = (f32x4){0.f, 0.f, 0.f, 0.f};
                dw = __builtin_amdgcn_mfma_f32_16x16x32_bf16(aw0, wf[nt][0], dw, 0, 0, 0); dw = __builtin_amdgcn_mfma_f32_16x16x32_bf16(aw1, wf[nt][1], dw, 0, 0, 0);
                da = __builtin_amdgcn_mfma_f32_16x16x32_bf16(aa0, af[nt][0], da, 0, 0, 0); da = __builtin_amdgcn_mfma_f32_16x16x32_bf16(aa1, af[nt][1], da, 0, 0, 0);
#pragma unroll
                for (int r = 0; r < 4; ++r) { DW[(g4 * 4 + r) * 64 + nt * 16 + fr] = dw[r]; DA[(g4 * 4 + r) * 64 + nt * 16 + fr] = da[r]; }
            }
        }
#pragma unroll 1
        for (int hh = 0; hh < 2; ++hh) {
            const int nh = nb + 8 * hh;
            if (nh >= n1) break;
            float ur[10], rr[9], kr[9], vr[9], bbv[8], zbv[8];
#pragma unroll
            for (int i = 0; i < 10; ++i) { const bf16_t* q = P + ROWC(nh - 2 + i); ur[i] = bf2f(q[2688 + tid]) * bf2f(q[3200 + tid]); }
#pragma unroll
            for (int i = 0; i < 9; ++i) { const bf16_t* q = P + ROWC(nh - 1 + i); rr[i] = bf2f(q[tid]); kr[i] = bf2f(q[512 + tid]); vr[i] = bf2f(q[1024 + tid]); }
#pragma unroll
            for (int i = 0; i < 8; ++i) { const bf16_t* q = P + ROWC(nh + i); bbv[i] = bf2f(q[2176 + tid]); zbv[i] = bf2f(q[3712 + tid]); }
#pragma unroll
            for (int i = 0; i < 8; ++i) { const int n = nh + i;
                if (n < n1) {
                    int b, t, T; const bool samp = n >= NP;
                    if (!samp) { b = n >> 11; t = n & 2047; T = SEQ; } else { const int s = n - NP; b = s >> 3; t = s & 7; T = ST; }
                    const float cr = rr[i + 1], ck = kr[i + 1], cv = vr[i + 1];
                    float qr = rr[i], qk = kr[i], qv = vr[i];
                    if (t == 0) { qr = 0.f; qk = 0.f; qv = 0.f; if (samp) { qr = sshift[b * ASW + tid]; qk = sshift[b * ASW + 512 + tid]; qv = sshift[b * ASW + 1024 + tid]; } }
                    const float sr = cr + (qr - cr) * mu_r, sk = ck + (qk - ck) * mu_k, sv = cv + (qv - cv) * mu_v;
                    const float wp = w0 + DW[(hh * 8 + i) * 64 + lane], ap = a0 + DA[(hh * 8 + i) * 64 + lane];
                    const float xs = -wp;
                    const float sp = xs > 20.f ? xs : __logf(1.f + __expf(xs));
                    const float decay = __expf(-__expf(-sp - 0.5f));
                    const float a = 1.f / (1.f + __expf(-ap));
                    const float kk = sk * k_k;
                    const float ss = wave_sum(kk * kk);
                    const float kkn = kk * rsqrtf(fmaxf(ss, 1e-24f));
                    const float kmod = sk * (1.f + (a - 1.f) * k_a);
                    const float bon = wave_sum(sr * kmod * r_k);
                    const size_t o = (size_t)n * 512 + tid;
                    SR[o] = sr; SW[o] = decay; SK[o] = kmod; SV[o] = sv; SKK[o] = kkn; SBB[o] = kkn * a;
                    if (lane == 0) BON[(size_t)n * 8 + wave] = bon;
                    if (t == T - 1) {
                        float* so = p.out + (samp ? O_SH_S + (size_t)(j * SB + b) * ASW : O_SH_P + (size_t)(j * PB + b) * ASW);
                        so[tid] = cr; so[512 + tid] = ck; so[1024 + tid] = cv; if (tid < 128) so[1536 + tid] = bf2f(P[(size_t)n * EINP + 1536 + tid]);
                    }
                    const float u0 = ur[i + 2];
                    float um1 = ur[i + 1], um2 = ur[i];
                    if (t < 1) um1 = samp ? sconv[(b * 2 + 1) * 512 + tid] : 0.f;
                    if (t < 2) um2 = samp ? sconv[(b * 2 + t) * 512 + tid] : 0.f;
                    const float yc = cw0 * um2 + cw1 * um1 + cw2 * u0;
                    MIX[(size_t)n * DM + 512 + tid] = (bf16_t)f2bf(bbv[i] * yc * silu(zbv[i]));
                    if (t >= T - 2) { float* co = p.out + (samp ? O_CV_S + (size_t)((j * SB + b) * 2 + (t - (T - 2))) * 512 : O_CV_P + (size_t)((j * PB + b) * 2 + (t - (T - 2))) * 512); co[tid] = u0; }
                } }
        }
    }
    __syncthreads();
#undef ROWC
}

constexpr int KVC_N0 = 32 * 128 * 256, KVC_N1 = 32 * 512 * 256, KVC_N2 = 32 * 2048 * 256, KVC_TOT = KVC_N0 + KVC_N1 + KVC_N2;
constexpr int CPS = 2;
__device__ __forceinline__ bool kvc_addr(const Params& p, int j, int i, const f32x4*& src, f32x4*& dst) {
    const size_t lbase = (size_t)j * SB * 2048 * 1024;
    src = (const f32x4*)(p.in[7] + lbase) + i; dst = (f32x4*)(p.out + O_KV2048_S + lbase) + (i - 2048);
    return i < KVC_N2 && ((i >> 8) & 2047) >= 8;
}
__device__ __forceinline__ void even_scan(const Params& p, int j, LAS unsigned char* lds, int gw, int NGW, int wave, int lane) {
    unsigned char* ws = p.ws;
    unsigned char* wss = ws + (size_t)j * SET_STRIDE;
    float* YL = (float*)(ws + WS_YL); float* QQ = (float*)(wss + WS_Q);
    float* LC = (float*)(ws + WS_LC); float* PC = (float*)(ws + WS_PC);
    LAS float* buf = (LAS float*)(lds + wave * 12288);
    const float* A0 = (const float*)(wss + WS_SC + 4 * SC_STRIDE);
    const float* A1 = (const float*)(wss + WS_SC + 1 * SC_STRIDE);
    const float* A2 = (const float*)(wss + WS_SC + 5 * SC_STRIDE);
    const float* A3 = (const float*)(wss + WS_SC + 2 * SC_STRIDE);
    const float* A4 = (const float*)(wss + WS_SC + 0 * SC_STRIDE);
    const float* A5 = (const float*)(wss + WS_SC + 3 * SC_STRIDE);
    const int ls = lane >> 4, lq = (lane & 15) * 4;
    const int cstride = CPS * NGW * 64; int cli = gw * 64 + lane;
    const size_t clb = (size_t)j * SB * 2048 * 1024;
    const f32x4* csrc = (const f32x4*)(p.in[7] + clb) + cli;
    const long long cdelta = (long long)((const char*)(p.out + O_KV2048_S + clb) - (const char*)(p.in[7] + clb)) - 2048 * 16;
    int cstep = 0;
    for (int task = gw; task < 64 * NCH + SB * 8 * 8; task += NGW) {
        const bool samp = task >= 64 * NCH;
        if (samp && ((task - 64 * NCH) & 7) != 0) continue;
        int n0, h, nst; size_t sidx;
        if (!samp) { const int bh = task / NCH, c = task % NCH; n0 = (bh >> 3) * SEQ + c * CH; h = bh & 7; nst = CH / TS; sidx = (size_t)task; }
        else { const int q = (task - 64 * NCH) >> 3, b = q >> 3; h = q & 7; n0 = NP + b * ST; nst = ST / TS; sidx = (size_t)(j * SB + b) * 8 + h; }
        float SL[4][16], SP[4][16];
        int i16 = lane & 15, cq = lane >> 4; asm volatile("" : "+v"(i16), "+v"(cq));
#pragma unroll
        for (int rr = 0; rr < 4; ++rr)
#pragma unroll
            for (int c = 0; c < 16; ++c) { SL[rr][c] = 0.f; SP[rr][c] = (i16 + 16 * rr == cq * 16 + c) ? 1.f : 0.f; }
        if (samp) {
#pragma unroll
            for (int rr = 0; rr < 4; ++rr) { const float* s0 = p.in[2] + sidx * 4096 + (i16 + 16 * rr) * 64 + cq * 16;
#pragma unroll
                for (int c = 0; c < 16; c += 4) { const f32x4 v = *(const f32x4*)(s0 + c); SL[rr][c] = v[0]; SL[rr][c + 1] = v[1]; SL[rr][c + 2] = v[2]; SL[rr][c + 3] = v[3]; } }
        }
        const size_t base = (size_t)n0 * 512 + h * 64;
        f32x4 rg[6];
        { const size_t o = base + (size_t)ls * 512 + lq;
          rg[0] = *(const f32x4*)(A0 + o); rg[1] = *(const f32x4*)(A1 + o); rg[2] = *(const f32x4*)(A2 + o); rg[3] = *(const f32x4*)(A3 + o); rg[4] = *(const f32x4*)(A4 + o); rg[5] = *(const f32x4*)(A5 + o);
#pragma unroll
          for (int a = 0; a < 6; ++a) *(LAS f32x4*)(buf + ls * 384 + a * 64 + lq) = rg[a]; }
        for (int st = 0; st < nst; ++st) {
            const bool more = st + 1 < nst;
            if (more) { const size_t o = base + (size_t)((st + 1) * TS + ls) * 512 + lq;
                rg[0] = *(const f32x4*)(A0 + o); rg[1] = *(const f32x4*)(A1 + o); rg[2] = *(const f32x4*)(A2 + o); rg[3] = *(const f32x4*)(A3 + o); rg[4] = *(const f32x4*)(A4 + o); rg[5] = *(const f32x4*)(A5 + o); }
            LAS float* bb = buf + (st & 1) * (TS * 384);
#pragma unroll 1
            for (int s = 0; s < TS; ++s) {
                const LAS float* sb = bb + s * 384 + cq * 16;
                f32x4 cbuf[CPS];
#pragma unroll
                for (int c = 0; c < CPS; ++c) { const int li = cli + c * NGW * 64;
                    if (li < KVC_N2 && ((li >> 8) & 2047) >= 8) cbuf[c] = __builtin_nontemporal_load(csrc + c * NGW * 64); }
                float saL[4], saP[4];
#pragma unroll
                for (int rr = 0; rr < 4; ++rr) { saL[rr] = 0.f; saP[rr] = 0.f; }
#pragma unroll
                for (int c = 0; c < 16; c += 4) { const f32x4 k4 = *(const LAS f32x4*)(sb + c);
#pragma unroll
                    for (int rr = 0; rr < 4; ++rr)
#pragma unroll
                        for (int e = 0; e < 4; ++e) { saL[rr] = fnma_s(SL[rr][c + e], k4[e], saL[rr]); saP[rr] = fnma_s(SP[rr][c + e], k4[e], saP[rr]); } }
                float vv[4];
#pragma unroll
                for (int rr = 0; rr < 4; ++rr) { vv[rr] = bb[s * 384 + 320 + i16 + 16 * rr];
                }
                {
                    float a = saL[0], b = saL[1], c = saL[2], d = saL[3]; swap16_(a, b); swap16_(c, d); float s01 = a + b, s23 = c + d; swap32_(s01, s23); const float T = s01 + s23;
                    float u = T, w = T; swap16_(u, w); float x0 = u, x2 = u, x1 = w, x3 = w; swap32_(x0, x2); swap32_(x1, x3); saL[0] = x0; saL[1] = x1; saL[2] = x2; saL[3] = x3;
                }
                {
                    float a = saP[0], b = saP[1], c = saP[2], d = saP[3]; swap16_(a, b); swap16_(c, d); float s01 = a + b, s23 = c + d; swap32_(s01, s23); const float T = s01 + s23;
                    float u = T, w = T; swap16_(u, w); float x0 = u, x2 = u, x1 = w, x3 = w; swap32_(x0, x2); swap32_(x1, x3); saP[0] = x0; saP[1] = x1; saP[2] = x2; saP[3] = x3;
                }
                float yL[4], yP[4];
#pragma unroll
                for (int rr = 0; rr < 4; ++rr) { yL[rr] = 0.f; yP[rr] = 0.f; }
#pragma unroll
                for (int c = 0; c < 16; c += 4) {
                    const f32x4 w4 = *(const LAS f32x4*)(sb + 64 + c), b4 = *(const LAS f32x4*)(sb + 128 + c), k4 = *(const LAS f32x4*)(sb + 192 + c), r4 = *(const LAS f32x4*)(sb + 256 + c);
#pragma unroll
                    for (int rr = 0; rr < 4; ++rr)
#pragma unroll
                        for (int e = 0; e < 4; ++e) {
                            float tL = mul_s(saL[rr], b4[e]); tL = fma_s(vv[rr], k4[e], tL); SL[rr][c + e] = fma_s(SL[rr][c + e], w4[e], tL); yL[rr] = fma_s(SL[rr][c + e], r4[e], yL[rr]);
                            const float tP = mul_s(saP[rr], b4[e]); SP[rr][c + e] = fma_s(SP[rr][c + e], w4[e], tP); yP[rr] = fma_s(SP[rr][c + e], r4[e], yP[rr]); }
                }
                float yoL, yoP;
                { float a = yL[0], b = yL[1], c = yL[2], d = yL[3]; swap16_(a, b); swap16_(c, d); float s01 = a + b, s23 = c + d; swap32_(s01, s23); yoL = s01 + s23; }
                { float a = yP[0], b = yP[1], c = yP[2], d = yP[3]; swap16_(a, b); swap16_(c, d); float s01 = a + b, s23 = c + d; swap32_(s01, s23); yoP = s01 + s23; }
                const size_t oo = base + (size_t)(st * TS + s) * 512 + lane;
                YL[oo] = yoL; if (!samp) QQ[oo] = yoP;
#pragma unroll
                for (int c = 0; c < CPS; ++c) { const int li = cli + c * NGW * 64;
                    if (li < KVC_N2 && ((li >> 8) & 2047) >= 8) __builtin_nontemporal_store(cbuf[c], (f32x4*)((char*)(csrc + c * NGW * 64) + cdelta)); }
                cli += cstride; csrc += cstride; ++cstep;
            }
            if (more) {
#pragma unroll
                for (int a = 0; a < 6; ++a) *(LAS f32x4*)(buf + ((st + 1) & 1) * (TS * 384) + ls * 384 + a * 64 + lq) = rg[a]; }
        }
        {
            float* dl = samp ? p.out + O_RWKV_S + sidx * 4096 : LC + sidx * 4096; float* dp = PC + sidx * 4096;
#pragma unroll
            for (int rr = 0; rr < 4; ++rr) { const int ro = (i16 + 16 * rr) * 64 + cq * 16;
#pragma unroll
                for (int c = 0; c < 16; c += 4) { *(f32x4*)(dl + ro + c) = (f32x4){SL[rr][c], SL[rr][c + 1], SL[rr][c + 2], SL[rr][c + 3]};
                    if (!samp) *(f32x4*)(dp + ro + c) = (f32x4){SP[rr][c], SP[rr][c + 1], SP[rr][c + 2], SP[rr][c + 3]}; } }
        }
    }
    for (; cli < KVC_N2; cli += NGW * 64, csrc += NGW * 64) { if (((cli >> 8) & 2047) >= 8) __builtin_nontemporal_store(__builtin_nontemporal_load(csrc), (f32x4*)((char*)csrc + cdelta)); }
}

typedef float f32x4c __attribute__((ext_vector_type(4)));
__device__ __forceinline__ void even_carry(const Params& p, int j, LAS unsigned char* lds, const int wave_s) {
    unsigned char* ws = p.ws;
    const float* LC = (const float*)(ws + WS_LC); const float* PC = (const float*)(ws + WS_PC); float* SST = (float*)(ws + WS_SST);
    LAS float* Ss = (LAS float*)lds;
    const int lane = pg8_opaque_lane(), fr = lane & 15, g4 = lane >> 4, ct = wave_s;
    for (int unit = blockIdx.x; unit < 256; unit += gridDim.x) {
        const int bh = unit >> 2, r0 = (unit & 3) * 16;
        const size_t cb0 = (size_t)(bh * NCH) * 4096;
        if (ct < 4) {
            float pr[4][16]; f32x4c lr[4];
#define CARRY_LOAD(Q, C) do { const float* pc_ = PC + cb0 + (size_t)(C) * 4096 + g4 * 64 + ct * 16 + fr; \
                _Pragma("unroll") for (int kk = 0; kk < 16; ++kk) pr[Q][kk] = pc_[kk * 256]; \
                const float* lc_ = LC + cb0 + (size_t)(C) * 4096 + (size_t)(r0 + g4 * 4) * 64 + ct * 16 + fr; \
                lr[Q] = (f32x4c){lc_[0], lc_[64], lc_[128], lc_[192]}; } while (0)
            CARRY_LOAD(0, 0); CARRY_LOAD(1, 1); CARRY_LOAD(2, 2); CARRY_LOAD(3, 3);
            f32x4c d = (f32x4c){0.f, 0.f, 0.f, 0.f};
            for (int c4 = 0; c4 < NCH; c4 += 4) {
#pragma unroll
                for (int q = 0; q < 4; ++q) {
                    const int c = c4 + q;
                    float* sst = SST + cb0 + (size_t)c * 4096 + (size_t)(r0 + g4 * 4) * 64 + ct * 16 + fr;
                    LAS float* sb = Ss + (c & 1) * 1024;
#pragma unroll
                    for (int r = 0; r < 4; ++r) { sst[r * 64] = d[r]; sb[(g4 * 4 + r) * 64 + ct * 16 + fr] = d[r]; }
                    __syncthreads();
                    f32x4c acc = lr[q];
#pragma unroll
                    for (int kk = 0; kk < 16; ++kk) acc = __builtin_amdgcn_mfma_f32_16x16x4f32(sb[fr * 64 + kk * 4 + g4], pr[q][kk], acc, 0, 0, 0);
                    d = acc;
                    if (c + 4 < NCH) CARRY_LOAD(q, c + 4);
                }
            }
#pragma unroll
            for (int r = 0; r < 4; ++r) p.out[O_RWKV_P + (size_t)(j * 64 + bh) * 4096 + (size_t)(r0 + g4 * 4 + r) * 64 + ct * 16 + fr] = d[r];
#undef CARRY_LOAD
        } else {
            for (int c = 0; c < NCH; ++c) __syncthreads();
        }
        __syncthreads();
    }
}

__device__ __forceinline__ void even_finish_vals(float y, float gg, float gb, float bon, float v, float zA, bf16_t* dst) {
    const float mean = wave_sum(y) * (1.f / 64.f);
    const float d = y - mean;
    const float var = wave_sum(d * d) * (1.f / 64.f);
    const float yn = d * rsqrtf(var + 64e-5f) * gg + gb + bon * v;
    *dst = (bf16_t)f2bf(yn * silu(zA));
}

__device__ __forceinline__ void even_fixup(const Params& p, int j, LAS unsigned char* lds, int gw, int NGW, int wave, int lane) {
    unsigned char* ws = p.ws;
    unsigned char* wss = ws + (size_t)j * SET_STRIDE;
    const float* YL = (const float*)(ws + WS_YL); const float* QQ = (const float*)(wss + WS_Q); const float* SST = (const float*)(ws + WS_SST);
    const float* BON = (const float*)(ws + WS_BON); const float* SV = (const float*)(wss + WS_SC + 3 * SC_STRIDE);
    const bf16_t* P = (const bf16_t*)(ws + WS_P); bf16_t* MIX = (bf16_t*)(ws + WS_MIX);
    LAS float* qb = (LAS float*)(lds + wave * 16384);
    const int fr = lane & 15, g4 = lane >> 4;
    for (int task = gw; task < 64 * NCH; task += NGW) {
        const int bh = task / NCH, c = task % NCH, b = bh >> 3, h = bh & 7, nb = b * SEQ + c * CH;
        { const float* qg = QQ + (size_t)nb * 512 + h * 64 + (lane & 15) * 4;
          f32x4 t[16];
#pragma unroll
          for (int i = 0; i < 16; ++i) t[i] = *(const f32x4*)(qg + (size_t)(i * 4 + (lane >> 4)) * 512);
#pragma unroll
          for (int i = 0; i < 16; ++i) *(LAS f32x4*)(qb + (i * 4 + (lane >> 4)) * 64 + (lane & 15) * 4) = t[i]; }
        float Sb[4][16], gg[4], gb[4];
        const float* s0 = SST + (size_t)task * 4096 + fr * 64 + g4;
#pragma unroll
        for (int it = 0; it < 4; ++it) { gg[it] = p.in[18][j * 512 + h * 64 + it * 16 + fr]; gb[it] = p.in[19][j * 512 + h * 64 + it * 16 + fr];
#pragma unroll
            for (int kk = 0; kk < 16; ++kk) Sb[it][kk] = s0[it * 1024 + kk * 4]; }
#pragma unroll 1
        for (int tt = 0; tt < 4; ++tt) {
            float yl[4][4], vv[4][4], za[4][4], bon[4];
#pragma unroll
            for (int r = 0; r < 4; ++r) { const size_t n = (size_t)(nb + tt * 16 + g4 * 4 + r); bon[r] = BON[n * 8 + h];
#pragma unroll
                for (int it = 0; it < 4; ++it) { const int ch = h * 64 + it * 16 + fr; yl[r][it] = YL[n * 512 + ch]; vv[r][it] = SV[n * 512 + ch]; za[r][it] = bf2f(P[n * EINP + ASW + ch]); } }
            f32x4 acc[4];
#pragma unroll
            for (int it = 0; it < 4; ++it) acc[it] = (f32x4){0.f, 0.f, 0.f, 0.f};
#pragma unroll
            for (int kk = 0; kk < 16; ++kk) { const float av = qb[(tt * 16 + fr) * 64 + kk * 4 + g4];
#pragma unroll
                for (int it = 0; it < 4; ++it) acc[it] = __builtin_amdgcn_mfma_f32_16x16x4f32(av, Sb[it][kk], acc[it], 0, 0, 0); }
#pragma unroll
            for (int r = 0; r < 4; ++r) {
                float y[4];
#pragma unroll
                for (int it = 0; it < 4; ++it) y[it] = acc[it][r] + yl[r][it];
                const float mean = row16_sum((y[0] + y[1]) + (y[2] + y[3])) * (1.f / 64.f);
#pragma unroll
                for (int it = 0; it < 4; ++it) y[it] -= mean;
                const float var = row16_sum((y[0] * y[0] + y[1] * y[1]) + (y[2] * y[2] + y[3] * y[3])) * (1.f / 64.f);
                const float rs = rsqrtf(var + 64e-5f);
                const size_t n = (size_t)(nb + tt * 16 + g4 * 4 + r);
#pragma unroll
                for (int it = 0; it < 4; ++it) { const float yn = y[it] * rs * gg[it] + gb[it] + bon[r] * vv[r][it];
                    MIX[n * DM + h * 64 + it * 16 + fr] = (bf16_t)f2bf(yn * silu(za[r][it])); }
            }
        }
    }
    for (int task = gw; task < NS * 8; task += NGW) {
        const int n = NP + (task >> 3), h = task & 7, ch = h * 64 + lane;
        even_finish_vals(YL[(size_t)n * 512 + ch], p.in[18][j * 512 + ch], p.in[19][j * 512 + ch], BON[(size_t)n * 8 + h], SV[(size_t)n * 512 + ch], bf2f(P[(size_t)n * EINP + ASW + ch]), MIX + (size_t)n * DM + ch);
    }
}

__device__ __forceinline__ void attn_prompt(const Params& p, int j, LAS unsigned char* lds, const int wave, const int lane) {
    unsigned char* ws = p.ws;
    const bf16_t* P = (const bf16_t*)(ws + WS_P);
    bf16_t* OG = (bf16_t*)(ws + WS_OG); float* LSE = (float*)(ws + WS_LSE);
    LAS unsigned char* Kl = lds;
    LAS unsigned char* Vl = lds + 39424;
    const int fr = lane & 15, g4 = lane >> 4, tid = wave * 64 + lane;
    typedef short s16x4_ __attribute__((ext_vector_type(4)));
    u32x4 kreg[5], vreg[5]; bf16x8 qn0, qn1;
#define ATT_DECODE(BT, G_, DSH_, RHO_, B_, H_, Q0B_) const int G_ = (BT) >> 10, r_ = (BT) & 1023, DSH_ = G_ * 2, tb_ = (SEQ >> DSH_) >> 7, qb_ = r_ % tb_, r2_ = r_ / tb_, \
        RHO_ = r2_ & ((1 << DSH_) - 1), bh_ = r2_ >> DSH_, B_ = bh_ >> 3, H_ = bh_ & 7, Q0B_ = qb_ * 128
#define ATT_LOAD(BT) do { ATT_DECODE(BT, g_, dsh_, rho_, b_, h_, q0b_); const bf16_t* Pb_ = P + (size_t)b_ * SEQ * OIN + g_ * 512 + h_ * 64; \
        _Pragma("unroll") for (int i = 0; i < 5; ++i) { const int idx = tid + 512 * i; if (idx < 2176) { int uk = q0b_ - 144 + (idx >> 3); uk = uk < 0 ? 0 : uk; \
            const bf16_t* rp = Pb_ + (size_t)((uk << dsh_) + rho_) * OIN + (idx & 7) * 8; kreg[i] = *(const u32x4*)(rp + 1536); vreg[i] = *(const u32x4*)(rp + 3072); } } \
        { const bf16_t* qp_ = Pb_ + (size_t)(((q0b_ + 16 * wave + fr) << dsh_) + rho_) * OIN + g4 * 8; qn0 = *(const bf16x8*)qp_; qn1 = *(const bf16x8*)(qp_ + 32); } } while (0)
    int bt = blockIdx.x;
    if (bt < 3072) ATT_LOAD(bt);
    for (; bt < 3072; bt += gridDim.x) {
#pragma unroll
        for (int i = 0; i < 5; ++i) { const int idx = tid + 512 * i; if (idx < 2176) { const int row = idx >> 3, ch = idx & 7;
            *(LAS u32x4*)(Kl + row * 144 + ch * 16) = kreg[i];
            *(LAS u32x2*)(Vl + row * 136 + ch * 16) = (u32x2){vreg[i].x, vreg[i].y}; *(LAS u32x2*)(Vl + row * 136 + ch * 16 + 8) = (u32x2){vreg[i].z, vreg[i].w}; } }
        __syncthreads();
        const bf16x8 qf0 = qn0, qf1 = qn1;
        if (bt + (int)gridDim.x < 3072) ATT_LOAD(bt + (int)gridDim.x);
        ATT_DECODE(bt, g, dsh, rho, b, h, q0b);
        const int q0 = q0b + 16 * wave;
        const bf16_t* Pb = P + (size_t)b * SEQ * OIN + g * 512 + h * 64;
        const int tq = ((q0 + fr) << dsh) + rho;
        f32x4 acc[4];
#pragma unroll
        for (int dt = 0; dt < 4; ++dt) acc[dt] = (f32x4){0.f, 0.f, 0.f, 0.f};
        float mrun = -1e30f, lrun = 0.f;
        const int uq = q0 + fr;
        const int kp0 = q0 >= 113 ? 0 : (113 - q0 + 31) / 32;
        for (int kp = kp0; kp < 5; ++kp) {
            const int kbase = q0 - 144 + 32 * kp, lrow = 16 * wave + 32 * kp;
            f32x4 st[2];
#pragma unroll
            for (int tl = 0; tl < 2; ++tl) {
                const LAS unsigned char* kr = Kl + (lrow + tl * 16 + fr) * 144 + g4 * 16;
                const bf16x8 kf0 = *(const LAS bf16x8*)kr, kf1 = *(const LAS bf16x8*)(kr + 64);
                f32x4 sv = (f32x4){0.f, 0.f, 0.f, 0.f};
                sv = __builtin_amdgcn_mfma_f32_16x16x32_bf16(kf0, qf0, sv, 0, 0, 0);
                sv = __builtin_amdgcn_mfma_f32_16x16x32_bf16(kf1, qf1, sv, 0, 0, 0);
                st[tl] = sv;
            }
            float mx = -1e30f; bool val[2][4];
#pragma unroll
            for (int tl = 0; tl < 2; ++tl)
#pragma unroll
                for (int e = 0; e < 4; ++e) { const int uk = kbase + tl * 16 + g4 * 4 + e, dist = uq - uk; val[tl][e] = (uk >= 0) && (dist >= 0) && (dist <= 128);
                    st[tl][e] = val[tl][e] ? st[tl][e] * 0.125f : -1e30f; mx = fmaxf(mx, st[tl][e]); }
            mx = xmax4(mx);
            const float mnew = fmaxf(mrun, mx), sc = __expf(mrun - mnew);
            mrun = mnew; lrun *= sc;
#pragma unroll
            for (int dt = 0; dt < 4; ++dt) acc[dt] = acc[dt] * sc;
            float pv[2][4];
#pragma unroll
            for (int tl = 0; tl < 2; ++tl)
#pragma unroll
                for (int e = 0; e < 4; ++e) { pv[tl][e] = val[tl][e] ? __expf(st[tl][e] - mnew) : 0.f; lrun += pv[tl][e]; }
            bf16x8 pf;
            { u32x4 w; w.x = pk2(pv[0][0], pv[0][1]); w.y = pk2(pv[0][2], pv[0][3]); w.z = pk2(pv[1][0], pv[1][1]); w.w = pk2(pv[1][2], pv[1][3]); pf = __builtin_bit_cast(bf16x8, w); }
#pragma unroll
            for (int dt = 0; dt < 4; ++dt) {
                LAS unsigned char* ta = Vl + (lrow + g4 * 4 + (fr >> 2)) * 136 + dt * 32 + 8 * (fr & 3);
                const s16x4_ lo = __builtin_amdgcn_ds_read_tr16_b64_v4i16((LAS s16x4_*)ta), hi = __builtin_amdgcn_ds_read_tr16_b64_v4i16((LAS s16x4_*)(ta + 2176));
                const bf16x8 vf = (bf16x8){lo[0], lo[1], lo[2], lo[3], hi[0], hi[1], hi[2], hi[3]};
                acc[dt] = __builtin_amdgcn_mfma_f32_16x16x32_bf16(vf, pf, acc[dt], 0, 0, 0);
            }
        }
        lrun = xsum4(lrun);
        const float inv = 1.f / lrun;
        const size_t n = (size_t)b * SEQ + tq;
        bf16_t* og = OG + ((size_t)g * NP + n) * 512 + h * 64 + g4 * 4;
#pragma unroll
        for (int dt = 0; dt < 4; ++dt) { u32x2 w; w.x = pk2(acc[dt][0] * inv, acc[dt][1] * inv); w.y = pk2(acc[dt][2] * inv, acc[dt][3] * inv); *(u32x2*)(og + dt * 16) = w; }
        if (g4 == 0) LSE[((size_t)g * NP + n) * 8 + h] = mrun + __logf(lrun);
        __syncthreads();
    }
#undef ATT_LOAD
#undef ATT_DECODE
}

__device__ __forceinline__ void attn_sample(const Params& p, int j, LAS unsigned char* lds, int gw, int NGW, int wave, int lane) {
    unsigned char* ws = p.ws;
    const bf16_t* P = (const bf16_t*)(ws + WS_P);
    LAS float* scs = (LAS float*)(lds + 40960 + wave * 2560);
    const int rs = lane >> 4, ch = lane & 15;
    for (int task = gw; task < NS * 8; task += NGW) {
        const int t = task & 7, h = (task >> 3) & 7, b = task >> 6, s = b * 8 + t, n = NP + s;
        f32x4 qv[3];
#pragma unroll
        for (int g = 0; g < 3; ++g) { const u32x2 w = *(const u32x2*)(P + (size_t)n * OIN + g * 512 + h * 64 + ch * 4);
            qv[g] = (f32x4){__uint_as_float(w.x << 16), __uint_as_float(w.x & 0xffff0000u), __uint_as_float(w.y << 16), __uint_as_float(w.y & 0xffff0000u)} * 0.125f; }
        float mx = -1e30f;
#pragma unroll
        for (int g = 0; g < 3; ++g) {
            const int W = g == 0 ? 128 : (g == 1 ? 512 : 2048), dsh = 2 * g;
            const float* cache = (g == 0 ? p.in[5] : (g == 1 ? p.in[6] : p.in[7])) + (size_t)(j * SB + b) * W * 1024 + h * 64 + ch * 4;
            const float* nbuf = p.out + (g == 0 ? O_KV128_S : (g == 1 ? O_KV512_S : O_KV2048_S)) + (size_t)(j * SB + b) * W * 1024 + h * 64 + ch * 4;
#pragma unroll 1
            for (int jj0 = 0; jj0 < 129; jj0 += 64) {
                f32x4 kv[16];
#pragma unroll
                for (int u = 0; u < 16; ++u) { int jj = jj0 + u * 4 + rs; jj = jj > 128 ? 128 : jj; const int pos = W + t - (jj << dsh);
                    kv[u] = *(const f32x4*)(pos >= W ? nbuf + (size_t)(pos - 8) * 1024 : cache + (size_t)pos * 1024); }
#pragma unroll
                for (int u = 0; u < 16; ++u) { const int jj = jj0 + u * 4 + rs;
                    const float d = row16_sum(kv[u][0] * qv[g][0] + kv[u][1] * qv[g][1] + kv[u][2] * qv[g][2] + kv[u][3] * qv[g][3]);
                    if (jj <= 128) { mx = fmaxf(mx, d); if (ch == 0) scs[g * 129 + jj] = d; } }
            }
        }
        mx = wave_max(mx);
        float lsum = 0.f;
        for (int i = lane; i < 387; i += 64) { const float e = __expf(scs[i] - mx); scs[i] = e; lsum += e; }
        lsum = wave_sum(lsum);
        f32x4 acc = (f32x4){0.f, 0.f, 0.f, 0.f};
#pragma unroll
        for (int g = 0; g < 3; ++g) {
            const int W = g == 0 ? 128 : (g == 1 ? 512 : 2048), dsh = 2 * g;
            const float* cache = (g == 0 ? p.in[5] : (g == 1 ? p.in[6] : p.in[7])) + (size_t)(j * SB + b) * W * 1024 + 512 + h * 64 + ch * 4;
            const float* nbuf = p.out + (g == 0 ? O_KV128_S : (g == 1 ? O_KV512_S : O_KV2048_S)) + (size_t)(j * SB + b) * W * 1024 + 512 + h * 64 + ch * 4;
#pragma unroll 1
            for (int jj0 = 0; jj0 < 129; jj0 += 64) {
                f32x4 vv[16]; float pj[16];
#pragma unroll
                for (int u = 0; u < 16; ++u) { int jj = jj0 + u * 4 + rs; const bool ok = jj <= 128; jj = ok ? jj : 128; const int pos = W + t - (jj << dsh);
                    vv[u] = *(const f32x4*)(pos >= W ? nbuf + (size_t)(pos - 8) * 1024 : cache + (size_t)pos * 1024);
                    pj[u] = ok ? scs[g * 129 + jj] : 0.f; }
#pragma unroll
                for (int u = 0; u < 16; ++u) acc += vv[u] * pj[u];
            }
        }
        acc[0] = xsum4(acc[0]); acc[1] = xsum4(acc[1]); acc[2] = xsum4(acc[2]); acc[3] = xsum4(acc[3]);
        if (rs == 0) {
            const float inv = 1.f / lsum;
            const u32x2 zw = *(const u32x2*)(P + (size_t)n * OIN + 4608 + h * 64 + ch * 4);
            const float z0 = __uint_as_float(zw.x << 16), z1 = __uint_as_float(zw.x & 0xffff0000u), z2 = __uint_as_float(zw.y << 16), z3 = __uint_as_float(zw.y & 0xffff0000u);
            u32x2 o; o.x = pk2(acc[0] * inv * silu(z0), acc[1] * inv * silu(z1)); o.y = pk2(acc[2] * inv * silu(z2), acc[3] * inv * silu(z3));
            *(u32x2*)((bf16_t*)(ws + WS_MIX) + (size_t)n * 512 + h * 64 + ch * 4) = o;
        }
    }
}

__device__ __forceinline__ void kv_copy(const Params& p, int j, int gw, int NGW, int lane) {
#pragma unroll
    for (int g = 0; g < 2; ++g) {
        const int W = g == 0 ? 128 : (g == 1 ? 512 : 2048);
        const float* cache = (g == 0 ? p.in[5] : (g == 1 ? p.in[6] : p.in[7])) + (size_t)j * SB * W * 1024;
        float* ob = p.out + (g == 0 ? O_KV128_S : (g == 1 ? O_KV512_S : O_KV2048_S)) + (size_t)j * SB * W * 1024;
        const long per = (long)(W - 8) * 256, tot = per * SB;
        for (long i0 = (long)gw * 512 + lane; i0 < tot; i0 += (long)NGW * 512) {
            f32x4 v[8];
#pragma unroll
            for (int u = 0; u < 8; ++u) { const long i = i0 + u * 64; if (i < tot) { const long b = i / per, o = i - b * per; v[u] = __builtin_nontemporal_load((const f32x4*)(cache + (b * W + 8) * 1024) + o); } }
#pragma unroll
            for (int u = 0; u < 8; ++u) { const long i = i0 + u * 64; if (i < tot) { const long b = i / per, o = i - b * per; __builtin_nontemporal_store(v[u], (f32x4*)(ob + b * W * 1024) + o); } }
        }
    }
}

__device__ __forceinline__ void attn_merge(const Params& p, int gw, int NGW, int lane) {
    unsigned char* ws = p.ws;
    const bf16_t* P = (const bf16_t*)(ws + WS_P); const bf16_t* OG = (const bf16_t*)(ws + WS_OG); const float* LSE = (const float*)(ws + WS_LSE);
    bf16_t* MIX = (bf16_t*)(ws + WS_MIX);
    const int h = lane >> 3;
    float nl0 = 0.f, nl1 = 0.f, nl2 = 0.f; u32x4 na = {0u, 0u, 0u, 0u}, nb = na, nc = na, nz = na;
#define MERGE_LOAD(N) do { const size_t n_ = (size_t)(N); nl0 = LSE[((size_t)0 * NP + n_) * 8 + h]; nl1 = LSE[((size_t)1 * NP + n_) * 8 + h]; nl2 = LSE[((size_t)2 * NP + n_) * 8 + h]; \
        na = *(const u32x4*)(OG + ((size_t)0 * NP + n_) * 512 + lane * 8); nb = *(const u32x4*)(OG + ((size_t)1 * NP + n_) * 512 + lane * 8); \
        nc = *(const u32x4*)(OG + ((size_t)2 * NP + n_) * 512 + lane * 8); nz = *(const u32x4*)(P + n_ * OIN + 4608 + lane * 8); } while (0)
    if (gw < NP) MERGE_LOAD(gw);
    for (int n = gw; n < NP; n += NGW) {
        const float l0 = nl0, l1 = nl1, l2 = nl2; const u32x4 a = na, bq = nb, c = nc, z = nz;
        if (n + NGW < NP) MERGE_LOAD(n + NGW);
        const float m = fmaxf(l0, fmaxf(l1, l2));
        float e0 = __expf(l0 - m), e1 = __expf(l1 - m), e2 = __expf(l2 - m);
        const float inv = 1.f / (e0 + e1 + e2); e0 *= inv; e1 *= inv; e2 *= inv;
        u32x4 o;
#pragma unroll
        for (int i = 0; i < 4; ++i) {
            const float alo = __uint_as_float(a[i] << 16), ahi = __uint_as_float(a[i] & 0xffff0000u), blo = __uint_as_float(bq[i] << 16), bhi = __uint_as_float(bq[i] & 0xffff0000u);
            const float clo = __uint_as_float(c[i] << 16), chi = __uint_as_float(c[i] & 0xffff0000u), zlo = __uint_as_float(z[i] << 16), zhi = __uint_as_float(z[i] & 0xffff0000u);
            const float olo = (e0 * alo + e1 * blo + e2 * clo) * silu(zlo), ohi = (e0 * ahi + e1 * bhi + e2 * chi) * silu(zhi);
            o[i] = pk2(olo, ohi);
        }
        *(u32x4*)(MIX + (size_t)n * 512 + lane * 8) = o;
    }
#undef MERGE_LOAD
}


#define RLX_AGENT __ATOMIC_RELAXED, __HIP_MEMORY_SCOPE_AGENT
#define XB_TMO      128
#define XB_XCNT(j)  (256  + 64 * (j))
#define XB_XSUB(j)  (1280 + 64 * (j))
#define XB_XGEN(j)  (2304 + 64 * (j))
#define XB_TOP      3328
#define XB_TOPGEN   3392
#define XCD_BAR_WORDS 3456
#define XB_SPIN_CAP (1u << 18)

__device__ __forceinline__ unsigned xb_ld(unsigned* p)              { return __hip_atomic_load(p, __ATOMIC_RELAXED, __HIP_MEMORY_SCOPE_AGENT); }
__device__ __forceinline__ unsigned xb_add(unsigned* p, unsigned v) { return __hip_atomic_fetch_add(p, v, __ATOMIC_RELAXED, __HIP_MEMORY_SCOPE_AGENT); }
__device__ __forceinline__ unsigned xb_xcc_id() { return (unsigned)__builtin_amdgcn_s_getreg((3 << 11) | 20) & 0xFu; }
#define XB_SPIN(cond, bar) do { unsigned _sp = 0; while (cond) { __builtin_amdgcn_s_sleep(1); \
    if ((++_sp & 255u) == 0u) { if (xb_ld(&(bar)[XB_TMO])) break; if (_sp > XB_SPIN_CAP) { atomicAdd(&(bar)[XB_TMO], 1u); break; } } } } while (0)

struct XcdBarrier {
    unsigned* bar; unsigned x; int wv;
    volatile LAS unsigned* st;
};

__device__ __forceinline__ XcdBarrier xcd_barrier_post(unsigned* bar, volatile LAS unsigned* st, int wv) {
    XcdBarrier b; b.bar = bar; b.x = xb_xcc_id(); b.st = st; b.wv = wv;
    if (wv == 0 && pg8_opaque_lane() == 0) (void)xb_add(&bar[XB_XCNT(b.x)], 1u);
    return b;
}
__device__ __forceinline__ void xcd_barrier_complete(unsigned* bar, unsigned x, unsigned& nloc, unsigned& nx) {
    const unsigned G = gridDim.x * gridDim.y * gridDim.z;
    unsigned sum, cnt, mine, sp = 0u;
    for (;;) {
        sum = 0u; cnt = 0u; mine = 0u;
#pragma unroll
        for (unsigned j = 0; j < 16; ++j) { const unsigned c = xb_ld(&bar[XB_XCNT(j)]); sum += c; cnt += (c > 0u) ? 1u : 0u; mine = (j == x) ? c : mine; }
        if (sum == G) break;
        __builtin_amdgcn_s_sleep(1);
        if ((++sp & 255u) == 0u) { if (xb_ld(&bar[XB_TMO])) break; if (sp > XB_SPIN_CAP) { atomicAdd(&bar[XB_TMO], 1u); break; } }
    }
    nloc = mine > 0u ? mine : 1u; nx = cnt > 0u ? cnt : 1u;
}

__device__ __forceinline__ void xcd_barrier(const XcdBarrier& b) {
    asm volatile("s_waitcnt vmcnt(0)" ::: "memory");
    __syncthreads();
    if (b.wv == 0 && pg8_opaque_lane() == 0) {
        unsigned* bar = b.bar;
        __builtin_amdgcn_s_waitcnt(0);
        unsigned nloc = b.st[0], nx = b.st[1];
        if (nloc == 0u) { xcd_barrier_complete(bar, b.x, nloc, nx); b.st[0] = nloc; b.st[1] = nx; }
        const unsigned old = xb_add(&bar[XB_XSUB(b.x)], 1u);
        const unsigned gen = old / nloc;
        if (old + 1u == (gen + 1u) * nloc) {
            __builtin_amdgcn_fence(__ATOMIC_RELEASE, "agent");
            asm volatile("s_waitcnt vmcnt(0)" ::: "memory");
            const unsigned og = xb_add(&bar[XB_TOP], 1u);
            const unsigned tg = og / nx;
            if (og + 1u == (tg + 1u) * nx) xb_add(&bar[XB_TOPGEN], 1u);
            else XB_SPIN(xb_ld(&bar[XB_TOPGEN]) == tg, bar);
            __builtin_amdgcn_fence(__ATOMIC_ACQUIRE, "agent");
            xb_add(&bar[XB_XGEN(b.x)], 1u);
            asm volatile("s_waitcnt vmcnt(0)" ::: "memory");
        } else {
            XB_SPIN(xb_ld(&bar[XB_XGEN(b.x)]) == gen, bar);
            __builtin_amdgcn_fence(__ATOMIC_ACQUIRE, "agent");
            asm volatile("s_waitcnt vmcnt(0)" ::: "memory");
        }
    }
    __syncthreads();
}


__device__ __forceinline__ void sample_outproj(const bf16_t* MIXp, const bf16_t* Wt, int K, const float* Xs  , float* Z, int gw, int NGW, int lane) {
    const int fr = lane & 15, g4 = lane >> 4;
    for (int task = gw; task < 16 * 64; task += NGW) {
        const int rt = task >> 6, ct = task & 63;
        const bf16_t* ap = MIXp + (size_t)(NP + rt * 16 + fr) * K + g4 * 8;
        const bf16_t* bp = Wt + (size_t)(ct * 16 + fr) * K + g4 * 8;
        f32x4 acc = (f32x4){0.f, 0.f, 0.f, 0.f};
#pragma unroll 8
        for (int ks = 0; ks < K / 32; ++ks) { const bf16x8 a = *(const bf16x8*)(ap + ks * 32), b = *(const bf16x8*)(bp + ks * 32);
            acc = __builtin_amdgcn_mfma_f32_16x16x32_bf16(a, b, acc, 0, 0, 0); }
#pragma unroll
        for (int r = 0; r < 4; ++r) { const size_t os = (size_t)(rt * 16 + g4 * 4 + r) * DM + ct * 16 + fr; Z[(size_t)NP * DM + os] = Xs[os] * ALPHA + acc[r]; }
    }
}

#ifndef PHM
#define PHM 0xFFFF
#endif
#ifndef PHDUP
#define PHDUP 0
#endif
#define PH(b) for (int _r = 0; _r < ((((PHDUP) >> (b)) & 1) ? 2 : 1); ++_r) if constexpr (((PHM) >> (b)) & 1)
#ifndef SYNCDUP
#define SYNCDUP 0
#endif
#define GSYNC() do { for (int _q = 0; _q <= SYNCDUP; ++_q) xcd_barrier(xbar); } while (0)
__global__ void __launch_bounds__(512, 2) fwd_megakernel(Params p) {
    extern __shared__ __attribute__((aligned(16))) unsigned char lds_raw[];
    cg::grid_group grid = cg::this_grid();
    LAS unsigned char* lds = (LAS unsigned char*)lds_raw;
    const int G = gridDim.x, NGW = G * 8;
    const int wave_s = __builtin_amdgcn_readfirstlane(threadIdx.x >> 6);
#define LAUNDER() int wave_ = wave_s; asm volatile("" : "+s"(wave_)); const int lane = pg8_opaque_lane(), wave = wave_, gw = blockIdx.x * 8 + wave; (void)lane; (void)gw;
    unsigned char* ws = p.ws;
    float* Xf = (float*)(ws + WS_XF); bf16_t* Xb = (bf16_t*)(ws + WS_XB); bf16_t* Pm = (bf16_t*)(ws + WS_P);
    float* Z = (float*)(ws + WS_Z); bf16_t* MIX = (bf16_t*)(ws + WS_MIX);

    for (int u = wave_s * 64 + pg8_opaque_lane(); u < (LDS_BYTES - 131072) / 4; u += 512) ((LAS unsigned*)(lds + 131072))[u] = 0u;
    __syncthreads();
    XcdBarrier xbar = xcd_barrier_post((unsigned*)(p.ws + WS_CTL), (volatile LAS unsigned*)(lds + MISC_OFF) + 8, wave_s);
    PH(0) { LAUNDER(); phase0(p, lds, gw, NGW, wave, lane); }
    if (p.ws == nullptr) grid.sync();
    GSYNC();
#pragma unroll 1
    for (int li = 0; li < 4; ++li) {
        const int j = li >> 1;
        if ((li & 1) == 0) {
            PH(1) { pg8::Gemm g{Xb, (const bf16_t*)(ws + WS_WEI) + (size_t)j * EINP * 1024, MTOK, EINP, 1024}; pg8::StaticOrder S; S.init(MTOK, EINP, G, (int)blockIdx.x);
              pg8::EpiStoreBf16 E{Pm, EINP};
              pg8::gemm_phase<pg8::EpiStoreBf16, pg8::StaticOrder, true, true>(lds, g, S, E, wave_s); }
            GSYNC();
            PH(2) even_prep(p, j, lds, wave_s);
            GSYNC();
            PH(3) { LAUNDER(); even_scan(p, j, lds, gw, NGW, wave, lane); }
            GSYNC();
            PH(4) even_carry(p, j, lds, wave_s);
            GSYNC();
            PH(5) { LAUNDER(); even_fixup(p, j, lds, gw, NGW, wave, lane); }
            GSYNC();
            PH(6) { LAUNDER(); sample_outproj(MIX, (const bf16_t*)(ws + WS_WEO) + (size_t)j * 1024 * 1024, 1024, li == 0 ? p.in[1] : Xf + (size_t)NP * DM, Z, gw, NGW, lane); }
            PH(6) { pg8::Gemm g{MIX, (const bf16_t*)(ws + WS_WEO) + (size_t)j * 1024 * 1024, NP, 1024, 1024}; pg8::StaticOrder S; S.init(NP, 1024, G, (int)blockIdx.x);
              pg8::EpiResid E{li == 0 ? p.in[0] : Xf, Z};
              pg8::gemm_phase<pg8::EpiResid, pg8::StaticOrder, true, true>(lds, g, S, E, wave_s); }
            GSYNC();
        } else {
            PH(7) { pg8::Gemm g{Xb, (const bf16_t*)(ws + WS_WOI) + (size_t)j * OIN * 1024, MTOK, OIN, 1024}; pg8::StaticOrder S; S.init(MTOK, OIN, G, (int)blockIdx.x);
              pg8::EpiOddIn E{Pm, p.out, j};
              pg8::gemm_phase<pg8::EpiOddIn, pg8::StaticOrder, true, true>(lds, g, S, E, wave_s); }
            GSYNC();
            PH(8) { LAUNDER(); attn_prompt(p, j, lds, wave, lane); }
            PH(9) { LAUNDER(); attn_sample(p, j, lds, gw, NGW, wave, lane); }
            PH(10) { LAUNDER(); kv_copy(p, j, gw, NGW, lane); }
            GSYNC();
            PH(11) { LAUNDER(); attn_merge(p, gw, NGW, lane); }
            GSYNC();
            PH(12) { LAUNDER(); sample_outproj(MIX, (const bf16_t*)(ws + WS_WOO) + (size_t)j * 1024 * 512, 512, Xf + (size_t)NP * DM, Z, gw, NGW, lane); }
            PH(12) { pg8::Gemm g{MIX, (const bf16_t*)(ws + WS_WOO) + (size_t)j * 1024 * 512, NP, 1024, 512}; pg8::StaticOrder S; S.init(NP, 1024, G, (int)blockIdx.x);
              pg8::EpiResid E{Xf, Z};
              pg8::gemm_phase<pg8::EpiResid, pg8::StaticOrder, true, true>(lds, g, S, E, wave_s); }
            GSYNC();
        }
        PH(13) { LAUNDER(); ln_phase(Z, p.in[23] + li * DM, p.in[24] + li * DM, li == 3 ? p.out + O_Y : Xf, Xb, gw, NGW, lane); }
        if (li < 3) GSYNC();
    }
}

extern "C" void kernel_launch(void* const* d_in, const int* in_sizes, int n_in, void* d_out, int out_size, void* d_ws, size_t ws_size, hipStream_t stream) {
    static int grid_blocks = 0;
    if (grid_blocks == 0) {
        if (n_in != 25 || (size_t)out_size != O_END || ws_size < WS_END) { fprintf(stderr, "kernel_launch: unexpected shapes n_in %d out %d ws %zu\n", n_in, out_size, ws_size); grid_blocks = -1; return; }
        int dev = 0, cus = 0, per_cu = 0;
        hipGetDevice(&dev);
        hipDeviceGetAttribute(&cus, hipDeviceAttributeMultiprocessorCount, dev);
        if (hipFuncSetAttribute((const void*)fwd_megakernel, hipFuncAttributeMaxDynamicSharedMemorySize, LDS_BYTES) != hipSuccess) { fprintf(stderr, "kernel_launch: hipFuncSetAttribute failed\n"); grid_blocks = -1; return; }
        if (hipOccupancyMaxActiveBlocksPerMultiprocessor(&per_cu, (const void*)fwd_megakernel, 512, LDS_BYTES) != hipSuccess || per_cu < 1) { fprintf(stderr, "kernel_launch: occupancy query gave %d\n", per_cu); per_cu = 1; }
        (void)hipGetLastError();
        grid_blocks = cus * per_cu;
    }
    if (grid_blocks < 0) return;
    Params p{};
    for (int i = 0; i < 25; ++i) p.in[i] = (const float*)d_in[i];
    p.out = (float*)d_out; p.ws = (unsigned char*)d_ws;
    if (hipMemsetAsync((char*)d_ws + WS_CTL, 0, 16384, stream) != hipSuccess) { fprintf(stderr, "kernel_launch: memset failed\n"); return; }
    void* args[] = {&p};
    hipError_t e = hipLaunchCooperativeKernel((void*)fwd_megakernel, dim3(grid_blocks), dim3(512), args, LDS_BYTES, stream);
    if (e != hipSuccess) fprintf(stderr, "cooperative launch failed: %s (grid %d)\n", hipGetErrorString(e), grid_blocks);
}
```
